# Optimizing an MI355X kernel written in HIP

```python
import math
import jax, jax.numpy as jnp
from jax import lax
import numpy as np

D_MODEL = 1024
BATCH = 2
SEQ = 16384
DEPTH = 2

CHUNK = 64
N_META = 16
META_PAD = CHUNK - N_META
EPS = 1e-6
ROPE_THETA = 500000.0
Q_BLOCK = 128

A_HEADS = 4
A_DK = 64
A_DV = 2 * A_DK
A_ROT = A_DK // 4
A_QK_W = A_HEADS * 2 * A_DK
A_W = A_HEADS * A_DV

B_HEADS = 4
B_DK = 128
B_DV = 128
B_W = B_HEADS * B_DV
CONV_K = 4

C_HEADS = 8
C_DK = D_MODEL // C_HEADS
C_DV = D_MODEL // C_HEADS

D_FF = 2816
N_EXPERTS = 8
TOP_K = 2
D_FF_EXPERT = 3584
MOE_BLOCK = 256

N_EVEN = (DEPTH + 1) // 2
N_ODD = DEPTH // 2
EVEN_IN = 2 * A_QK_W + A_W + 4 * B_W + 2 * B_HEADS
ODD_IN = 4 * D_MODEL

kernel_name = 'hybrid_diffattn_gdn_hgrn2_moe'


def rmsnorm(x, g):
    xf = x.astype(jnp.float32)
    y = xf * lax.rsqrt(jnp.mean(xf * xf, axis=-1, keepdims=True) + EPS)
    return (y * g.astype(jnp.float32)).astype(x.dtype)


def l2norm(x):
    return x * lax.rsqrt(jnp.sum(x * x, axis=-1, keepdims=True) + EPS)


def chunk_ids(n):
    return (jnp.arange(n) + META_PAD) // CHUNK


def rope_partial(x, pos):
    half = A_ROT // 2
    inv_freq = ROPE_THETA ** (-jnp.arange(half, dtype=jnp.float32) * 2.0 / A_ROT)
    ang = pos.astype(jnp.float32)[:, None] * inv_freq[None, :]
    cos = jnp.cos(ang)[:, None, :].astype(x.dtype)
    sin = jnp.sin(ang)[:, None, :].astype(x.dtype)
    x1, x2, rest = x[..., :half], x[..., half:A_ROT], x[..., A_ROT:]
    return jnp.concatenate([x1 * cos - x2 * sin, x2 * cos + x1 * sin, rest], axis=-1)


def causal_conv(x, w):
    c = x.shape[-1]
    return lax.conv_general_dilated(x, w[:, None, :].astype(x.dtype), window_strides=(1,),
                                    padding=[(CONV_K - 1, 0)],
                                    dimension_numbers=('NWC', 'WIO', 'NWC'),
                                    feature_group_count=c)


def pad_front(t, n):
    return jnp.pad(t, [(0, 0), (n, 0)] + [(0, 0)] * (t.ndim - 2))


def to_chunks(t):
    b, lc, h, d = t.shape
    return t.reshape(b, lc // CHUNK, CHUNK, h, d).transpose(1, 0, 3, 2, 4)


def from_chunks(t):
    n, b, h, c, d = t.shape
    return t.transpose(1, 0, 3, 2, 4).reshape(b, n * c, h, d)


def diff_attention(q, k, v, q_gain, k_gain, lq1, lk1, lq2, lk2, sub_gain, layer):
    bn, L = q.shape[0], q.shape[1]
    pos = jnp.arange(L)
    q = rope_partial(rmsnorm(q, q_gain), pos)
    k = rope_partial(rmsnorm(k, k_gain), pos)
    n_blk = -(-L // Q_BLOCK)
    lp = n_blk * Q_BLOCK
    pad = [(0, 0), (0, lp - L), (0, 0), (0, 0)]
    q, k, v = jnp.pad(q, pad), jnp.pad(k, pad), jnp.pad(v, pad)
    cid = chunk_ids(lp)
    qh = q.transpose(0, 2, 1, 3)
    kh = k.transpose(0, 2, 1, 3)
    vh = v.transpose(0, 2, 1, 3)
    lam_init = 0.8 - 0.6 * math.exp(-0.3 * layer)
    f32 = jnp.float32
    lam = (jnp.exp(jnp.sum(lq1.astype(f32) * lk1.astype(f32)))
           - jnp.exp(jnp.sum(lq2.astype(f32) * lk2.astype(f32))) + lam_init)
    scale = A_DK ** -0.5
    q_blocks = qh.reshape(bn, 2 * A_HEADS, n_blk, Q_BLOCK, A_DK).transpose(2, 0, 1, 3, 4)
    c_blocks = cid.reshape(n_blk, Q_BLOCK)

    def block(args):
        qb, cb = args
        s = jnp.einsum('bhqd,bhkd->bhqk', qb, kh).astype(f32) * scale
        s = jnp.where(cid[None, :] <= cb[:, None], s, -jnp.inf)
        p = jax.nn.softmax(s, axis=-1).reshape(bn, A_HEADS, 2, Q_BLOCK, lp)
        attn = (p[:, :, 0] - lam * p[:, :, 1]).astype(vh.dtype)
        return jnp.einsum('bhqk,bhkd->bhqd', attn, vh)

    o = lax.map(block, (q_blocks, c_blocks))
    o = o.transpose(1, 0, 3, 2, 4).reshape(bn, lp, A_HEADS, A_DV)[:, :L]
    o = rmsnorm(o, sub_gain) * (1.0 - lam_init)
    return o.reshape(bn, L, A_W)


def gated_delta_rule(q, k, v, beta, g):
    f32 = jnp.float32
    q, k, v = (pad_front(t.astype(f32), META_PAD) for t in (q, k, v))
    beta, g = (pad_front(t.astype(f32), META_PAD)[..., None] for t in (beta, g))
    qc, kc, vc = to_chunks(q), to_chunks(k), to_chunks(v)
    bc, gc = to_chunks(beta)[..., 0], to_chunks(g)[..., 0]
    dv = vc.shape[-1]
    gcum = jnp.cumsum(gc, axis=-1)
    idx = jnp.arange(CHUNK)
    incl = idx[:, None] >= idx[None, :]
    strict = idx[:, None] > idx[None, :]
    dec = jnp.exp(jnp.where(incl, gcum[..., :, None] - gcum[..., None, :], -jnp.inf))
    kb = kc * bc[..., None]
    m = jnp.einsum('nbhid,nbhjd->nbhij', kb, kc) * jnp.where(strict, dec, 0.0)
    a = m + jnp.eye(CHUNK, dtype=f32)
    rhs = jnp.concatenate([vc * bc[..., None], kb * jnp.exp(gcum)[..., None]], axis=-1)
    sol = lax.linalg.triangular_solve(a, rhs, left_side=True, lower=True, unit_diagonal=True)
    u, w = sol[..., :dv], sol[..., dv:]
    qk = jnp.einsum('nbhid,nbhjd->nbhij', qc, kc) * dec
    qg = qc * jnp.exp(gcum)[..., None]
    glast = gcum[..., -1]
    kdec = kc * jnp.exp(glast[..., None] - gcum)[..., None]

    def step(S, xs):
        u_n, w_n, qk_n, qg_n, kdec_n, gl_n = xs
        v_new = u_n - jnp.einsum('bhcd,bhde->bhce', w_n, S)
        o = jnp.einsum('bhcd,bhde->bhce', qg_n, S) + jnp.einsum('bhij,bhje->bhie', qk_n, v_new)
        S = S * jnp.exp(gl_n)[..., None, None] + jnp.einsum('bhcd,bhce->bhde', kdec_n, v_new)
        return S, o

    s0 = jnp.zeros(qc.shape[1:3] + (qc.shape[-1], dv), f32)
    _, o = lax.scan(step, s0, (u, w, qk, qg, kdec, glast))
    return from_chunks(o)[:, META_PAD:]


def hgrn2_recurrence(q, k, i, logf):
    f32 = jnp.float32
    q, k, i, logf = (pad_front(t.astype(f32), META_PAD) for t in (q, k, i, logf))
    qc, kc, ic, lc = to_chunks(q), to_chunks(k), to_chunks(i), to_chunks(logf)
    gcum = jnp.cumsum(lc, axis=-2)
    glast = gcum[..., -1, :]
    qg = qc * jnp.exp(gcum)
    kdec = kc * jnp.exp(glast[..., None, :] - gcum)
    idx = jnp.arange(CHUNK)
    incl = (idx[:, None] >= idx[None, :])[:, :, None]

    def step(S, xs):
        q_n, k_n, i_n, gc_n, qg_n, kdec_n, gl_n = xs
        dec = jnp.exp(jnp.where(incl, gc_n[:, :, :, None, :] - gc_n[:, :, None, :, :], -jnp.inf))
        att = jnp.einsum('bhtsd,bhsd->bhts', dec * q_n[:, :, :, None, :], k_n)
        o = jnp.einsum('bhtd,bhde->bhte', qg_n, S) + jnp.einsum('bhts,bhse->bhte', att, i_n)
        S = jnp.exp(gl_n)[..., None] * S + jnp.einsum('bhsd,bhse->bhde', kdec_n, i_n)
        return S, o

    s0 = jnp.zeros(qc.shape[1:3] + (qc.shape[-1], ic.shape[-1]), f32)
    _, o = lax.scan(step, s0, (qc, kc, ic, gcum, qg, kdec, glast))
    return from_chunks(o)[:, META_PAD:]


def even_mixer(h, w_in, a_q_gain, a_k_gain, lq1, lk1, lq2, lk2, a_sub_gain,
               b_conv, b_a_log, b_dt_bias, b_out_gain, w_out, layer):
    bn, L, _ = h.shape
    proj = h @ w_in
    cuts = [A_QK_W, 2 * A_QK_W, 2 * A_QK_W + A_W, 2 * A_QK_W + A_W + 3 * B_W,
            2 * A_QK_W + A_W + 4 * B_W, 2 * A_QK_W + A_W + 4 * B_W + B_HEADS]
    aq, ak, av, bqkv, bz, bb, ba = jnp.split(proj, cuts, axis=-1)
    o_a = diff_attention(aq.reshape(bn, L, 2 * A_HEADS, A_DK), ak.reshape(bn, L, 2 * A_HEADS, A_DK),
                         av.reshape(bn, L, A_HEADS, A_DV), a_q_gain, a_k_gain, lq1, lk1, lq2, lk2,
                         a_sub_gain, layer)
    bqkv = jax.nn.silu(causal_conv(bqkv, b_conv))
    bq, bk, bv = jnp.split(bqkv, 3, axis=-1)
    f32 = jnp.float32
    shp = (bn, L, B_HEADS, B_DK)
    bq = l2norm(bq.reshape(shp).astype(f32)) * (B_DK ** -0.5)
    bk = l2norm(bk.reshape(shp).astype(f32))
    beta = jax.nn.sigmoid(bb.astype(f32))
    g = -jnp.exp(b_a_log.astype(f32)) * jax.nn.softplus(ba.astype(f32) + b_dt_bias.astype(f32))
    o_b = gated_delta_rule(bq, bk, bv.reshape(bn, L, B_HEADS, B_DV), beta, g).astype(h.dtype)
    o_b = rmsnorm(o_b, b_out_gain) * jax.nn.silu(bz.reshape(bn, L, B_HEADS, B_DV))
    o = jnp.concatenate([o_a, o_b.reshape(bn, L, B_W)], axis=-1)
    return o @ w_out


def odd_mixer(h, w_in, c_out_gain, w_out, lb):
    bn, L, _ = h.shape
    q, f, i, z = jnp.split(h @ w_in, 4, axis=-1)
    shp = (bn, L, C_HEADS, C_DK)
    lbh = lb.reshape(C_HEADS, C_DK)
    fg = lbh + (1.0 - lbh) * jax.nn.sigmoid(f.reshape(shp).astype(jnp.float32))
    o = hgrn2_recurrence(q.reshape(shp), 1.0 - fg, i.reshape(bn, L, C_HEADS, C_DV), jnp.log(fg))
    o = rmsnorm(o.astype(h.dtype), c_out_gain) * jax.nn.silu(z.reshape(bn, L, C_HEADS, C_DV))
    return o.reshape(bn, L, D_MODEL) @ w_out


def swiglu(x, w1, w3, w2):
    return (jax.nn.silu(x @ w1) * (x @ w3)) @ w2


def moe_swiglu(x, router, w1, w3, w2):
    bn, L, d = x.shape
    xf = x.reshape(-1, d)
    t = xf.shape[0]
    na = t * TOP_K
    logits = (xf @ router).astype(jnp.float32)
    top_v, top_i = lax.top_k(logits, TOP_K)
    gate = jax.nn.softmax(top_v, axis=-1)
    flat_e = top_i.reshape(-1).astype(jnp.int32)
    flat_tok = jnp.arange(na, dtype=jnp.int32) // TOP_K
    flat_g = gate.reshape(-1)
    order = jnp.argsort(flat_e)
    sorted_e = flat_e[order]
    counts = jnp.zeros(N_EXPERTS, jnp.int32).at[flat_e].add(1)
    padded = (counts + MOE_BLOCK - 1) // MOE_BLOCK * MOE_BLOCK
    start = jnp.cumsum(counts) - counts
    pend = jnp.cumsum(padded)
    pstart = pend - padded
    dest = pstart[sorted_e] + (jnp.arange(na, dtype=jnp.int32) - start[sorted_e])
    n_rows = -(-(na + N_EXPERTS * (MOE_BLOCK - 1)) // MOE_BLOCK) * MOE_BLOCK
    n_blk = n_rows // MOE_BLOCK
    row_tok = jnp.zeros(n_rows, jnp.int32).at[dest].set(flat_tok[order])
    row_gate = jnp.zeros(n_rows, jnp.float32).at[dest].set(flat_g[order])
    blk_e = jnp.minimum(jnp.searchsorted(pend, jnp.arange(n_blk, dtype=jnp.int32) * MOE_BLOCK,
                                         side='right'), N_EXPERTS - 1)

    def block(args):
        tok, gb, e = args
        xb = xf[tok]
        hb = jax.nn.silu(xb @ w1[e]) * (xb @ w3[e])
        return (hb @ w2[e]) * gb[:, None].astype(x.dtype)

    y = lax.map(block, (row_tok.reshape(n_blk, MOE_BLOCK), row_gate.reshape(n_blk, MOE_BLOCK), blk_e))
    out = jnp.zeros_like(xf).at[row_tok].add(y.reshape(n_rows, d))
    return out.reshape(bn, L, d)


def setup_inputs(seed: int = 0) -> dict:
    key = jax.random.key(seed)
    keys = jax.random.split(key, 40)
    ctr = [0]

    def nk():
        ctr[0] += 1
        return keys[ctr[0] - 1]

    def nrm(shape, scale):
        return jax.random.normal(nk(), shape, jnp.float32) * scale

    def gain(shape):
        return 1.0 + nrm(shape, 0.02)

    D = D_MODEL
    dt = jnp.exp(jax.random.uniform(nk(), (N_EVEN, B_HEADS), jnp.float32,
                                    minval=math.log(1e-3), maxval=math.log(1e-1)))
    return {
        'x': nrm((BATCH, SEQ, D), 1.0),
        'meta_tokens': nrm((N_META, D), 1.0),
        'lb_logits': nrm((DEPTH, D), 0.5),
        'mix_norm': gain((DEPTH, D)),
        'ffn_norm': gain((DEPTH, D)),
        'e_w_in': nrm((N_EVEN, D, EVEN_IN), D ** -0.5),
        'a_q_gain': gain((N_EVEN, A_DK)),
        'a_k_gain': gain((N_EVEN, A_DK)),
        'a_lam_q1': nrm((N_EVEN, A_DK), 0.1),
        'a_lam_k1': nrm((N_EVEN, A_DK), 0.1),
        'a_lam_q2': nrm((N_EVEN, A_DK), 0.1),
        'a_lam_k2': nrm((N_EVEN, A_DK), 0.1),
        'a_sub_gain': gain((N_EVEN, A_DV)),
        'b_conv': nrm((N_EVEN, CONV_K, 3 * B_W), CONV_K ** -0.5),
        'b_a_log': jnp.log(jax.random.uniform(nk(), (N_EVEN, B_HEADS), jnp.float32, minval=1.0, maxval=16.0)),
        'b_dt_bias': dt + jnp.log(-jnp.expm1(-dt)),
        'b_out_gain': gain((N_EVEN, B_DV)),
        'e_w_out': nrm((N_EVEN, A_W + B_W, D), (A_W + B_W) ** -0.5),
        'ffn_w1': nrm((N_EVEN, D, D_FF), D ** -0.5),
        'ffn_w3': nrm((N_EVEN, D, D_FF), D ** -0.5),
        'ffn_w2': nrm((N_EVEN, D_FF, D), D_FF ** -0.5),
        'o_w_in': nrm((N_ODD, D, ODD_IN), D ** -0.5),
        'c_out_gain': gain((N_ODD, C_DV)),
        'o_w_out': nrm((N_ODD, D, D), D ** -0.5),
        'router': nrm((N_ODD, D, N_EXPERTS), D ** -0.5),
        'moe_w1': nrm((N_ODD, N_EXPERTS, D, D_FF_EXPERT), D ** -0.5),
        'moe_w3': nrm((N_ODD, N_EXPERTS, D, D_FF_EXPERT), D ** -0.5),
        'moe_w2': nrm((N_ODD, N_EXPERTS, D_FF_EXPERT, D), D_FF_EXPERT ** -0.5),
    }


def reference(x, meta_tokens, lb_logits, mix_norm, ffn_norm, e_w_in, a_q_gain, a_k_gain,
              a_lam_q1, a_lam_k1, a_lam_q2, a_lam_k2, a_sub_gain, b_conv, b_a_log, b_dt_bias,
              b_out_gain, e_w_out, ffn_w1, ffn_w3, ffn_w2, o_w_in, c_out_gain, o_w_out,
              router, moe_w1, moe_w3, moe_w2):
    bn = x.shape[0]
    meta = jnp.broadcast_to(meta_tokens[None].astype(x.dtype), (bn, N_META, D_MODEL))
    h = jnp.concatenate([meta, x], axis=1)
    lb_all = jnp.cumsum(jax.nn.softmax(lb_logits.astype(jnp.float32), axis=0), axis=0)
    lb_all = lb_all - lb_all[0]
    for layer in range(DEPTH):
        j = layer // 2
        hn = rmsnorm(h, mix_norm[layer])
        if layer % 2 == 0:
            h = h + even_mixer(hn, e_w_in[j], a_q_gain[j], a_k_gain[j], a_lam_q1[j], a_lam_k1[j],
                               a_lam_q2[j], a_lam_k2[j], a_sub_gain[j], b_conv[j], b_a_log[j],
                               b_dt_bias[j], b_out_gain[j], e_w_out[j], layer)
            h = h + swiglu(rmsnorm(h, ffn_norm[layer]), ffn_w1[j], ffn_w3[j], ffn_w2[j])
        else:
            h = h + odd_mixer(hn, o_w_in[j], c_out_gain[j], o_w_out[j], lb_all[layer])
            h = h + moe_swiglu(rmsnorm(h, ffn_norm[layer]), router[j], moe_w1[j], moe_w3[j], moe_w2[j])
    return h[:, N_META:]
```

```cpp
#include <hip/hip_runtime.h>
#include <cstdio>
#include <cstdint>

#define GAS __attribute__((address_space(1)))
#define LAS __attribute__((address_space(3)))
typedef unsigned short bf16;
typedef unsigned v4u __attribute__((ext_vector_type(4)));
typedef unsigned v2u __attribute__((ext_vector_type(2)));
typedef float f32x2 __attribute__((ext_vector_type(2)));
typedef float f32x4 __attribute__((ext_vector_type(4)));
typedef float f32x16 __attribute__((ext_vector_type(16)));
typedef short bf16x8 __attribute__((ext_vector_type(8)));
typedef short s16x4_t __attribute__((ext_vector_type(4)));
typedef short bf16x4 __attribute__((ext_vector_type(4)));
typedef __bf16 hbf16x2 __attribute__((ext_vector_type(2)));
typedef GAS unsigned gu32;

constexpr int D = 1024, NB = 2, SEQ = 16384, NMETA = 16;
constexpr int MR = NB * SEQ;
constexpr int MROWS = MR + NB * NMETA;
constexpr int MP = 33024;
constexpr int LP = 16448;
constexpr int NCH = 257;
constexpr float EPS = 1e-6f;
constexpr int EIN = 3592, NPROJ0 = 3584, DFF = 2816, DFFE = 3584, NEXP = 8;

constexpr size_t MiB = 1u << 20;
constexpr size_t WS_CTL = 0, CTL_ZERO_BYTES = 1 * MiB;
constexpr size_t WS_HM = 1 * MiB;
constexpr size_t WS_BG = 2 * MiB;
constexpr size_t WS_ROUTE = 2 * MiB;
constexpr size_t WS_WIN0 = 4 * MiB, WS_WOUT0 = 11 * MiB, WS_W13 = 13 * MiB, WS_W2 = 24 * MiB, WS_WIN1 = 30 * MiB, WS_WOUT1 = 38 * MiB;
constexpr size_t WS_HN = 40 * MiB;
constexpr size_t WS_BIG = 105 * MiB;
constexpr size_t WS_END = 535 * MiB;
constexpr size_t WS_Q = WS_BIG, WS_K = WS_BIG + 33 * MiB, WS_VR = WS_BIG + 66 * MiB, WS_VT = WS_BIG + 99 * MiB, WS_BZ = WS_BIG + 132 * MiB;
constexpr size_t WS_CRAW = WS_BIG + 165 * MiB;
constexpr size_t WS_O = WS_CRAW;
constexpr size_t WS_SCAN0 = WS_BIG + 262 * MiB;
constexpr int DN_BLOB = 74240;
constexpr int DN_Q = 0, DN_W = 16384, DN_KT = 32768, DN_U = 49152, DN_QK = 65536, DN_GC = 73728;
static_assert(WS_SCAN0 + (size_t)NB * 4 * NCH * DN_BLOB <= WS_END, "scan0");
static_assert((size_t)NB * LP * 512 * 2 <= 33 * MiB && (size_t)NB * LP * 1536 * 2 <= 97 * MiB && (size_t)MP * 1024 * 2 <= 65 * MiB, "l0 map");
constexpr size_t WS_H0 = WS_BIG;
constexpr size_t WS_PROJ1 = WS_BIG;
constexpr size_t WS_SCAN1 = WS_BIG + 258 * MiB;
constexpr int HG_BLOB = 41472;
constexpr int HG_QG = 0, HG_ATT = 16384, HG_KDT = 24576, HG_DEC = 40960;
static_assert((size_t)MP * 4096 * 2 <= 258 * MiB && WS_SCAN1 + (size_t)NB * 8 * NCH * HG_BLOB <= WS_END, "l1 map");
constexpr size_t WS_O1 = WS_HN;
constexpr int HG_SC = 17, HG_NSC = 16;
constexpr size_t WS_SLOC = 4 * MiB;
constexpr size_t WS_SINT = 20 * MiB;
constexpr size_t WS_DECSC = 28 * MiB;
constexpr size_t WS_WM13 = WS_BIG, WS_WM2 = WS_BIG + 56 * MiB;
constexpr size_t WS_XG = WS_BIG + 84 * MiB;
constexpr int NROWS_MOE = 2 * MR + NEXP * 256;
constexpr size_t WS_Y = WS_BIG + 150 * MiB;
constexpr size_t WS_HMOE = WS_BIG + 282 * MiB;
constexpr int MOE_PASS_TILES = 128, MOE_H_TILES = 136;
constexpr float SC_X = 8.f, SC_W13 = 256.f, SC_H = 4.f, SC_W2 = 512.f;
static_assert(WS_WM2 + (size_t)NEXP * D * DFFE <= WS_XG && WS_XG + (size_t)NROWS_MOE * 1024 <= WS_Y && WS_Y + (size_t)NROWS_MOE * 2048 <= WS_HMOE && WS_HMOE + (size_t)MOE_H_TILES * 256 * DFFE <= WS_END, "moe map");
constexpr size_t RT_TOKINFO = 0;
constexpr size_t RT_WGCNT = 600 * 1024;
constexpr size_t RT_ROWGATE = 640 * 1024;
constexpr size_t RT_ROWTOK = 960 * 1024;
static_assert(RT_ROWTOK + (size_t)NROWS_MOE * 4 <= 2 * MiB && (size_t)MR * 16 <= RT_WGCNT && RT_ROWGATE + (size_t)NROWS_MOE * 4 <= RT_ROWTOK, "route map");

constexpr int CW_TMO = 0;
constexpr int CW_QHEAD = 64;
constexpr int CW_BAR = 4096;

constexpr int RING_BYTES = 131072;
constexpr int LDSCTL_OFF = RING_BYTES, MISC_OFF = LDSCTL_OFF + 320;
constexpr int PERS_OFF = RING_BYTES + 1024;
constexpr int PRIV_OFF = RING_BYTES + 2048;
constexpr int LDS_BYTES = 163840;

#define RLX_AGENT __ATOMIC_RELAXED, __HIP_MEMORY_SCOPE_AGENT
#define LDS_WAIT() asm volatile("s_waitcnt lgkmcnt(0)" ::: "memory")
#define VM_WAIT() asm volatile("s_waitcnt vmcnt(0)" ::: "memory")
__device__ __forceinline__ unsigned pk2(float lo, float hi) { f32x2 v = {lo, hi}; hbf16x2 b = __builtin_convertvector(v, hbf16x2); return __builtin_bit_cast(unsigned, b); }
__device__ __forceinline__ bf16 f2bf(float f) { return (bf16)(pk2(f, 0.f) & 0xffffu); }
__device__ __forceinline__ float bf2f(unsigned v) { return __uint_as_float(v << 16); }
__device__ __forceinline__ float bflo(unsigned w) { return __uint_as_float(w << 16); }
__device__ __forceinline__ float bfhi(unsigned w) { return __uint_as_float(w & 0xffff0000u); }
__device__ __forceinline__ float clamp8(float v) { return fminf(fmaxf(v, -448.f), 448.f); }
__device__ __forceinline__ unsigned pk4_fp8(float a, float b, float c, float d) { int w = 0; w = __builtin_amdgcn_cvt_pk_fp8_f32(clamp8(a), clamp8(b), w, false); w = __builtin_amdgcn_cvt_pk_fp8_f32(clamp8(c), clamp8(d), w, true); return (unsigned)w; }
__device__ __forceinline__ float wave_sum(float v) {
#pragma unroll
    for (int o = 1; o < 64; o <<= 1) v += __shfl_xor(v, o);
    return v;
}
__device__ __forceinline__ float fast_exp(float x) { return __builtin_amdgcn_exp2f(x * 1.4426950408889634f); }
__device__ __forceinline__ float sigmoidf_(float x) { return __builtin_amdgcn_rcpf(1.f + fast_exp(-x)); }
__device__ __forceinline__ float siluf_(float x) { return x * sigmoidf_(x); }
__device__ __forceinline__ int prow_of_r(int r) { return r < MR ? r + 64 * ((r >> 14) + 1) : ((r - MR) >> 4) * LP + 48 + ((r - MR) & 15); }
__device__ __forceinline__ int r_of_bp(int b, int pp) { return pp >= 64 ? b * SEQ + pp - 64 : MR + b * NMETA + pp - 48; }

#define XB_TMO      128
#define XB_XCNT(j)  (256  + 64 * (j))
#define XB_XSUB(j)  (1280 + 64 * (j))
#define XB_XGEN(j)  (2304 + 64 * (j))
#define XB_TOP      3328
#define XB_TOPGEN   3392
#define XCD_BAR_WORDS 3456
#define XB_SPIN_CAP (1u << 18)
__device__ __forceinline__ unsigned xb_ld(unsigned* p)              { return __hip_atomic_load(p, __ATOMIC_RELAXED, __HIP_MEMORY_SCOPE_AGENT); }
__device__ __forceinline__ unsigned xb_add(unsigned* p, unsigned v) { return __hip_atomic_fetch_add(p, v, __ATOMIC_RELAXED, __HIP_MEMORY_SCOPE_AGENT); }
__device__ __forceinline__ int lane_id_asm() { int l; asm volatile("v_mbcnt_lo_u32_b32 %0, -1, 0\n\tv_mbcnt_hi_u32_b32 %0, -1, %0" : "=&v"(l)); return l; }
#define LANE_ID() lane_id_asm()
__device__ __forceinline__ unsigned xb_xcc_id() { return (unsigned)__builtin_amdgcn_s_getreg((3 << 11) | 20) & 0xFu; }
#define XB_SPIN(cond, bar) do { unsigned _sp = 0; while (cond) { __builtin_amdgcn_s_sleep(1); \
    if ((++_sp & 255u) == 0u) { if (xb_ld(&(bar)[XB_TMO])) break; if (_sp > XB_SPIN_CAP) { atomicAdd(&(bar)[XB_TMO], 1u); break; } } } } while (0)
struct XcdBarrier { unsigned* bar; unsigned x; volatile LAS unsigned* st; int wv; };
__device__ __forceinline__ XcdBarrier xcd_barrier_post(unsigned* bar, volatile LAS unsigned* st, int wv) {
    XcdBarrier b; b.bar = bar; b.x = xb_xcc_id(); b.st = st; b.wv = wv;
    if (wv * 64 + LANE_ID() == 0) (void)xb_add(&bar[XB_XCNT(b.x)], 1u);
    return b;
}
__device__ __forceinline__ void xcd_barrier_complete(unsigned* bar, unsigned x, unsigned& nloc, unsigned& nx) {
    const unsigned G = gridDim.x * gridDim.y * gridDim.z;
    unsigned sum, cnt, mine, sp = 0u;
    for (;;) {
        sum = 0u; cnt = 0u; mine = 0u;
#pragma unroll
        for (unsigned j = 0; j < 16; ++j) { const unsigned c = xb_ld(&bar[XB_XCNT(j)]); sum += c; cnt += (c > 0u) ? 1u : 0u; mine = (j == x) ? c : mine; }
        if (sum == G) break;
        __builtin_amdgcn_s_sleep(1);
        if ((++sp & 255u) == 0u) { if (xb_ld(&bar[XB_TMO])) break; if (sp > XB_SPIN_CAP) { atomicAdd(&bar[XB_TMO], 1u); break; } }
    }
    nloc = mine > 0u ? mine : 1u; nx = cnt > 0u ? cnt : 1u;
}
__device__ __forceinline__ void xcd_barrier(const XcdBarrier& b) {
    asm volatile("s_waitcnt vmcnt(0)" ::: "memory");
    __syncthreads();
    if (b.wv * 64 + LANE_ID() == 0) {
        unsigned* bar = b.bar;
        __builtin_amdgcn_s_waitcnt(0);
        unsigned nloc = b.st[0], nx = b.st[1];
        if (nloc == 0u) { xcd_barrier_complete(bar, b.x, nloc, nx); b.st[0] = nloc; b.st[1] = nx; }
        const unsigned old = xb_add(&bar[XB_XSUB(b.x)], 1u);
        const unsigned gen = old / nloc;
        if (old + 1u == (gen + 1u) * nloc) {
            __builtin_amdgcn_fence(__ATOMIC_RELEASE, "agent");
            asm volatile("s_waitcnt vmcnt(0)" ::: "memory");
            const unsigned og = xb_add(&bar[XB_TOP], 1u);
            const unsigned tg = og / nx;
            if (og + 1u == (tg + 1u) * nx) xb_add(&bar[XB_TOPGEN], 1u);
            else XB_SPIN(xb_ld(&bar[XB_TOPGEN]) == tg, bar);
            __builtin_amdgcn_fence(__ATOMIC_ACQUIRE, "agent");
            xb_add(&bar[XB_XGEN(b.x)], 1u);
            asm volatile("s_waitcnt vmcnt(0)" ::: "memory");
        } else {
            XB_SPIN(xb_ld(&bar[XB_XGEN(b.x)]) == gen, bar);
            __builtin_amdgcn_fence(__ATOMIC_ACQUIRE, "agent");
            asm volatile("s_waitcnt vmcnt(0)" ::: "memory");
        }
    }
    __syncthreads();
}

#ifndef PG8_ALIGN
#define PG8_ALIGN 1
#endif
typedef int v4i_t __attribute__((ext_vector_type(4)));
typedef int v8i_t __attribute__((ext_vector_type(8)));
namespace pg8 {
constexpr int BM = 256, BK = 64, HALF = 128, HTB = HALF * BK * 2, NXCD = 8, WGM = 8;
__host__ __device__ __forceinline__ int lds_byte(int r, int c) { const int st = (r >> 4) * 2 + (c >> 5), rr = r & 15, cc = c & 31, ob = rr * 64 + cc * 2; return st * 1024 + (ob ^ (((ob >> 9) & 1) << 5)); }
__host__ __device__ __forceinline__ void stage_rc(int b, int& R, int& C) { const int st = b / 1024, sb = b % 1024, swz = sb ^ (((sb >> 9) & 1) << 5); R = (st >> 1) * 16 + swz / 64; C = (st & 1) * 32 + (swz % 64) / 2; }
__host__ __device__ __forceinline__ int perm32(int rho) { const int n = rho >> 4, i = rho & 15; return 8 * (i >> 2) + 4 * n + (i & 3); }

struct Unit { int pm, pn, arow, brow, orow, nrow; };
struct Gemm { const bf16* A; const bf16* Bt; int K; };

struct StaticOrder {
    int nM, nN, nwg, G, c, mvalid;
    __device__ void init(int nM_, int nN_, int G_, int c_, int mvalid_ = 1 << 30) { nM = nM_; nN = nN_; nwg = nM * nN; G = G_; c = c_; mvalid = mvalid_; }
    __device__ bool next(int i, Unit& u) const { return map((long)i * G + c, u); }
    __device__ bool map(long L, Unit& u) const {
        if (L >= nwg) return false;
        int wgid = (int)L; { const int q = nwg / NXCD, r = nwg % NXCD, xcd = wgid % NXCD, off = wgid / NXCD; wgid = (xcd < r ? xcd * (q + 1) : r * (q + 1) + (xcd - r) * q) + off; }
        const int nig = WGM * nN, gid = wgid / nig, fm = gid * WGM, gsz = (nM - fm) < WGM ? (nM - fm) : WGM;
        u.pm = fm + ((wgid % nig) % gsz); u.pn = (wgid % nig) / gsz; u.arow = u.pm * BM; u.brow = u.pn * BM; u.orow = u.pm * BM; { const int left = mvalid - u.pm * BM; u.nrow = left < BM ? left : BM; } return true;
    }
};

template <class Epi, class Sched, bool FP8 = false>
__device__ __forceinline__ void gemm_phase(const int wv, LAS unsigned char* lds, const Gemm g, const Sched& S, const Epi& E) {
    int tz_ = wv * 64 + LANE_ID(); asm volatile("" : "+v"(tz_));
    const int tid = tz_, wid = __builtin_amdgcn_readfirstlane(tid >> 6), lane = tid & 63, wr = wid >> 2, wc = wid & 3, fr = lane & 15, fq = lane >> 4;
    const int K = g.K, nt = K / BK;
    unsigned voffA[2], voffB[2];
#pragma unroll
    for (int i = 0; i < 2; ++i) { int R, C; stage_rc(tid * 16 + i * 8192, R, C); const int Rb = (R & ~31) + perm32(R & 31);
        voffA[i] = (unsigned)(R * K + C) * 2u; voffB[i] = (unsigned)(Rb * K + C) * 2u; }
    const size_t kstep = (size_t)(BK * 2);
    const size_t hstep = (size_t)HALF * K * 2;
    const size_t rstep = (size_t)K * 2;
    const unsigned ldsw = (unsigned)wid * 1024u;
    const int aoff = lds_byte(wr * 64 + fr, fq * 8), boff = lds_byte(wc * 32 + fr, fq * 8);
#define PG8_SA(b, h) (((b) * 2 + (h)) * HTB)
#define PG8_SB(b, h) ((4 + (b) * 2 + (h)) * HTB)
#define PG8_STAGE(bufoff, gbase, voff) do { _Pragma("unroll") for (int _i = 0; _i < 2; ++_i) \
        __builtin_amdgcn_global_load_lds((const unsigned*)((const char*)(gbase) + (voff)[_i]), (LAS unsigned*)(lds + (bufoff) + ldsw + _i * 8192), 16, 0, 0); } while (0)
#define PG8_LD8(base_) __builtin_shufflevector(*(const LAS v4i_t*)(base_), *(const LAS v4i_t*)((base_) + 1024), 0, 1, 2, 3, 4, 5, 6, 7)
#define PG8_LDA(dst, b, h) do { if constexpr (FP8) { _Pragma("unroll") for (int m = 0; m < 4; ++m) dst##8[m] = PG8_LD8(lds + PG8_SA(b, h) + aoff + m * 2048); } \
        else { _Pragma("unroll") for (int m = 0; m < 4; ++m) _Pragma("unroll") for (int k = 0; k < 2; ++k) dst[m][k] = *(const LAS bf16x8*)(lds + PG8_SA(b, h) + aoff + m * 2048 + k * 1024); } } while (0)
#define PG8_LDB(dst, b, h) do { if constexpr (FP8) { _Pragma("unroll") for (int n = 0; n < 2; ++n) dst##8[n] = PG8_LD8(lds + PG8_SB(b, h) + boff + n * 2048); } \
        else { _Pragma("unroll") for (int n = 0; n < 2; ++n) _Pragma("unroll") for (int k = 0; k < 2; ++k) dst[n][k] = *(const LAS bf16x8*)(lds + PG8_SB(b, h) + boff + n * 2048 + k * 1024); } } while (0)
#define PG8_MMA(ai, bj, At, Bt) do { __builtin_amdgcn_s_setprio(1); \
        if constexpr (FP8) { _Pragma("unroll") for (int m = 0; m < 4; ++m) _Pragma("unroll") for (int n = 0; n < 2; ++n) \
            acc[ai][bj][m][n] = __builtin_amdgcn_mfma_scale_f32_16x16x128_f8f6f4(Bt##8[n], At##8[m], acc[ai][bj][m][n], 0, 0, 0, 0x7F7F7F7F, 0, 0x7F7F7F7F); \
            _Pragma("unroll") for (int m = 0; m < 4; ++m) _Pragma("unroll") for (int n = 0; n < 2; ++n) asm volatile("" : "+v"(acc[ai][bj][m][n])); }     \
        else { _Pragma("unroll") for (int m = 0; m < 4; ++m) _Pragma("unroll") for (int n = 0; n < 2; ++n) _Pragma("unroll") for (int k = 0; k < 2; ++k) \
            acc[ai][bj][m][n] = __builtin_amdgcn_mfma_f32_16x16x32_bf16(Bt[n][k], At[m][k], acc[ai][bj][m][n], 0, 0, 0); } \
        __builtin_amdgcn_s_setprio(0); } while (0)
#define PG8_MM(ai, bj, At, Bt) do { if (full || ((ai) == 0 && wr == 0)) PG8_MMA(ai, bj, At, Bt); } while (0)
#define PG8_WAIT_V(n) asm volatile("s_waitcnt vmcnt(" #n ")" ::: "memory")
#define PG8_WAIT_L(n) asm volatile("s_waitcnt lgkmcnt(" #n ")" ::: "memory")
#define PG8_BAR __builtin_amdgcn_s_barrier()
#define PG8_SCHED __builtin_amdgcn_sched_barrier(0)
    Unit cur, nxt; int ui = 0;
    if (!S.next(0, cur)) return;
    f32x4 acc[2][2][4][2];
#pragma unroll
    for (int a = 0; a < 2; ++a)
#pragma unroll
        for (int b = 0; b < 2; ++b)
#pragma unroll
            for (int m = 0; m < 4; ++m)
#pragma unroll
                for (int n = 0; n < 2; ++n) acc[a][b][m][n] = (f32x4){0.f, 0.f, 0.f, 0.f};
    bf16x8 At[4][2], B0[2][2], B1[2][2]; v8i_t At8[4], B08[2], B18[2];
    const char* cA = (const char*)g.A + (size_t)cur.arow * rstep; const char* cB = (const char*)g.Bt + (size_t)cur.brow * rstep;
    PG8_STAGE(PG8_SB(0, 0), cB, voffB); PG8_STAGE(PG8_SB(0, 1), cB + hstep, voffB); PG8_STAGE(PG8_SA(0, 0), cA, voffA); PG8_STAGE(PG8_SA(0, 1), cA + hstep, voffA);
    if (wr == 1) PG8_BAR;
    PG8_WAIT_V(2); PG8_BAR;
    PG8_STAGE(PG8_SB(1, 0), cB + kstep, voffB); PG8_STAGE(PG8_SA(1, 0), cA + kstep, voffA); PG8_STAGE(PG8_SB(1, 1), cB + hstep + kstep, voffB);
    PG8_WAIT_V(6); PG8_BAR;
    for (;;) {
        const bool has_next = S.next(ui + 1, nxt);
        const char* nA = has_next ? (const char*)g.A + (size_t)nxt.arow * rstep : cA; const char* nB = has_next ? (const char*)g.Bt + (size_t)nxt.brow * rstep : cB;
        const bool full = cur.nrow > 32;
        for (int t = 0; t < nt; t += 2) {
            const bool last = (t == nt - 2);
            const char* a1 = cA + (size_t)(t + 1) * kstep;
            const char* a2 = last ? nA : cA + (size_t)(t + 2) * kstep; const char* b2 = last ? nB : cB + (size_t)(t + 2) * kstep;
            const char* a3 = a2 + kstep; const char* b3 = b2 + kstep;
            PG8_LDB(B0, 0, 0); PG8_LDB(B1, 0, 1); PG8_SCHED; PG8_LDA(At, 0, 0); PG8_STAGE(PG8_SA(1, 1), a1 + hstep, voffA);
            PG8_WAIT_V(8); PG8_WAIT_L(0); PG8_BAR; PG8_MM(0, 0, At, B0); PG8_MM(0, 1, At, B1); PG8_BAR; PG8_SCHED;
            PG8_LDA(At, 0, 1); PG8_STAGE(PG8_SB(0, 0), b2, voffB); PG8_STAGE(PG8_SB(0, 1), b2 + hstep, voffB); PG8_STAGE(PG8_SA(0, 0), a2, voffA);
            PG8_WAIT_V(8); PG8_WAIT_L(0); PG8_BAR; PG8_MM(1, 0, At, B0); PG8_MM(1, 1, At, B1); PG8_BAR; PG8_SCHED;
            PG8_LDB(B0, 1, 0); PG8_LDB(B1, 1, 1); PG8_SCHED; PG8_LDA(At, 1, 0); PG8_STAGE(PG8_SA(0, 1), a2 + hstep, voffA);
            PG8_WAIT_V(8); PG8_WAIT_L(0); PG8_BAR; PG8_MM(0, 0, At, B0); PG8_MM(0, 1, At, B1); PG8_BAR; PG8_SCHED;
            PG8_LDA(At, 1, 1); PG8_STAGE(PG8_SB(1, 0), b3, voffB); PG8_STAGE(PG8_SB(1, 1), b3 + hstep, voffB); PG8_STAGE(PG8_SA(1, 0), a3, voffA);
            PG8_WAIT_V(8); PG8_WAIT_L(0); PG8_BAR; PG8_MM(1, 0, At, B0); PG8_MM(1, 1, At, B1); PG8_BAR; PG8_SCHED;
        }
#if PG8_ALIGN
        if (wr == 0) PG8_BAR;
#endif
        E(acc, cur, wr, wc, fr, fq);
        if (!has_next) break;
#pragma unroll
        for (int a = 0; a < 2; ++a)
#pragma unroll
            for (int b = 0; b < 2; ++b)
#pragma unroll
                for (int m = 0; m < 4; ++m)
#pragma unroll
                    for (int n = 0; n < 2; ++n) acc[a][b][m][n] = (f32x4){0.f, 0.f, 0.f, 0.f};
        cur = nxt; cA = nA; cB = nB; ++ui;
#if PG8_ALIGN
        if (wr == 1) PG8_BAR;
#endif
    }
    PG8_WAIT_V(0);
#if !PG8_ALIGN
    if (wr == 0) PG8_BAR;
#endif
    PG8_BAR;
#undef PG8_SA
#undef PG8_SB
#undef PG8_STAGE
#undef PG8_LDA
#undef PG8_LDB
#undef PG8_LD8
#undef PG8_MMA
#undef PG8_MM
#undef PG8_WAIT_V
#undef PG8_WAIT_L
#undef PG8_BAR
#undef PG8_SCHED
}
}
using pg8::Unit;
typedef f32x4 Acc[2][2][4][2];

__device__ __forceinline__ v4u pack8(const f32x4& a, const f32x4& b) { v4u w; w.x = pk2(a[0], a[1]); w.y = pk2(a[2], a[3]); w.z = pk2(b[0], b[1]); w.w = pk2(b[2], b[3]); return w; }

struct EpiProj0 {
    bf16 *Q, *K, *VR, *CR, *BZ;
    __device__ __forceinline__ void operator()(const Acc& acc, const Unit& u, int wr, int wc, int fr, int fq) const {
        const int pn = u.pn; bf16* base; int ld, c0;
        if (pn < 2) { base = Q; ld = 512; c0 = pn * 256; } else if (pn < 4) { base = K; ld = 512; c0 = (pn - 2) * 256; } else if (pn < 6) { base = VR; ld = 512; c0 = (pn - 4) * 256; }
        else if (pn < 12) { base = CR; ld = 1536; c0 = (pn - 6) * 256; } else { base = BZ; ld = 512; c0 = (pn - 12) * 256; }
        c0 += wc * 32 + 8 * fq;
#pragma unroll
        for (int ai = 0; ai < 2; ++ai)
#pragma unroll
            for (int m = 0; m < 4; ++m) { const int r = u.orow + ai * 128 + wr * 64 + m * 16 + fr;
                if (r < MROWS) { bf16* rowp = base + (size_t)prow_of_r(r) * ld + c0;
#pragma unroll
                    for (int bj = 0; bj < 2; ++bj) *(v4u*)(rowp + bj * 128) = pack8(acc[ai][bj][m][0], acc[ai][bj][m][1]); } }
    }
};
struct EpiBf16 {
    bf16* O; int ld;
    __device__ __forceinline__ void operator()(const Acc& acc, const Unit& u, int wr, int wc, int fr, int fq) const {
        const int c0 = u.pn * 256 + wc * 32 + 8 * fq;
#pragma unroll
        for (int ai = 0; ai < 2; ++ai)
#pragma unroll
            for (int m = 0; m < 4; ++m) { bf16* rowp = O + (size_t)(u.orow + ai * 128 + wr * 64 + m * 16 + fr) * ld + c0;
#pragma unroll
                for (int bj = 0; bj < 2; ++bj) *(v4u*)(rowp + bj * 128) = pack8(acc[ai][bj][m][0], acc[ai][bj][m][1]); }
    }
};
struct EpiSwiglu {
    bf16* H; int ld;
    __device__ __forceinline__ void operator()(const Acc& acc, const Unit& u, int wr, int wc, int fr, int fq) const {
        const int c0 = u.pn * 128 + wc * 32 + 8 * fq;
#pragma unroll
        for (int ai = 0; ai < 2; ++ai)
#pragma unroll
            for (int m = 0; m < 4; ++m) { bf16* rowp = H + (size_t)(u.orow + ai * 128 + wr * 64 + m * 16 + fr) * ld + c0;
                f32x4 h0, h1;
#pragma unroll
                for (int j = 0; j < 4; ++j) { h0[j] = siluf_(acc[ai][0][m][0][j]) * acc[ai][1][m][0][j]; h1[j] = siluf_(acc[ai][0][m][1][j]) * acc[ai][1][m][1][j]; }
                *(v4u*)rowp = pack8(h0, h1); }
    }
};
struct EpiSwiglu8 {
    unsigned char* H; int ld; float inv;
    __device__ __forceinline__ void operator()(const Acc& acc, const Unit& u, int wr, int wc, int fr, int fq) const {
        const int c0 = u.pn * 128 + wc * 32 + 8 * fq;
#pragma unroll
        for (int ai = 0; ai < 2; ++ai)
#pragma unroll
            for (int m = 0; m < 4; ++m) { unsigned char* rowp = H + (size_t)(u.orow + ai * 128 + wr * 64 + m * 16 + fr) * ld + c0;
                float h[8];
#pragma unroll
                for (int j = 0; j < 4; ++j) { h[j] = SC_H * siluf_(acc[ai][0][m][0][j] * inv) * (acc[ai][1][m][0][j] * inv); h[4 + j] = SC_H * siluf_(acc[ai][0][m][1][j] * inv) * (acc[ai][1][m][1][j] * inv); }
                *(v2u*)rowp = (v2u){pk4_fp8(h[0], h[1], h[2], h[3]), pk4_fp8(h[4], h[5], h[6], h[7])}; }
    }
};
struct EpiResid {
    const float* src_real; const float* src_meta; int meta_mask; float* dst_real; float* dst_meta;
    __device__ __forceinline__ void operator()(const Acc& acc, const Unit& u, int wr, int wc, int fr, int fq) const {
        const int c0 = u.pn * 256 + wc * 32 + 8 * fq;
#pragma unroll
        for (int ai = 0; ai < 2; ++ai)
#pragma unroll
            for (int m = 0; m < 4; ++m) { const int r = u.orow + ai * 128 + wr * 64 + m * 16 + fr;
                if (r < MROWS) {
                    const float* s = (r < MR) ? src_real + (size_t)r * D : src_meta + (size_t)((r - MR) & meta_mask) * D;
                    float* d = (r < MR) ? dst_real + (size_t)r * D : dst_meta + (size_t)(r - MR) * D;
#pragma unroll
                    for (int bj = 0; bj < 2; ++bj) {
                        const f32x4 s0 = *(const f32x4*)(s + c0 + bj * 128), s1 = *(const f32x4*)(s + c0 + bj * 128 + 4);
                        *(f32x4*)(d + c0 + bj * 128) = s0 + acc[ai][bj][m][0]; *(f32x4*)(d + c0 + bj * 128 + 4) = s1 + acc[ai][bj][m][1]; } } }
    }
};
struct EpiMoeDown {
    bf16* Y; const float* rowgate; float inv;
    __device__ __forceinline__ void operator()(const Acc& acc, const Unit& u, int wr, int wc, int fr, int fq) const {
        const int c0 = u.pn * 256 + wc * 32 + 8 * fq;
#pragma unroll
        for (int ai = 0; ai < 2; ++ai)
#pragma unroll
            for (int m = 0; m < 4; ++m) { const int r = u.orow + ai * 128 + wr * 64 + m * 16 + fr; const float gt = rowgate[r] * inv;
                bf16* rowp = Y + (size_t)r * D + c0;
#pragma unroll
                for (int bj = 0; bj < 2; ++bj) *(v4u*)(rowp + bj * 128) = pack8(acc[ai][bj][m][0] * gt, acc[ai][bj][m][1] * gt); }
    }
};

struct InPtrs { const __attribute__((address_space(4))) unsigned long long* base;
    __device__ __forceinline__ const float* operator[](int i) const { return (const float*)base[i]; } };
struct Frame {
    LAS unsigned char* lds;
    volatile LAS unsigned* MISC;
    gu32* ctl;
    unsigned char* ws;
    int tid, lane, wave, vcu, G;
    InPtrs in;
    float* out;
};
enum { I_X = 0, I_META, I_LB, I_MIXN, I_FFNN, I_EWIN, I_AQG, I_AKG, I_LQ1, I_LK1, I_LQ2, I_LK2, I_ASUB, I_BCONV, I_BALOG, I_BDT, I_BOUTG, I_EWOUT,
       I_W1, I_W3, I_W2, I_OWIN, I_COUTG, I_OWOUT, I_ROUTER, I_MW1, I_MW3, I_MW2 };

template <int ILV>
__device__ __forceinline__ void transpose_item(const float* W, int ldw, int K, int N, bf16* WT, int row_off, LAS float* scr, int item, int lane) {
    const int nblk = N / 32, kb = item / nblk, nb = item % nblk, k0 = 64 * kb, n0 = 32 * nb;
    float wv_[32];
#pragma unroll
    for (int i = 0; i < 32; ++i) wv_[i] = W[(size_t)(k0 + 2 * i + (lane >> 5)) * ldw + n0 + (lane & 31)];
#pragma unroll
    for (int i = 0; i < 32; ++i) scr[(2 * i + (lane >> 5)) * 33 + (lane & 31)] = wv_[i];
    LDS_WAIT(); asm volatile("" ::: "memory");
    const int c = lane & 7;
#pragma unroll
    for (int j = 0; j < 4; ++j) { const int n = (lane >> 3) + 8 * j; const LAS float* s = scr + (8 * c) * 33 + n;
        v4u o; o.x = pk2(s[0 * 33], s[1 * 33]); o.y = pk2(s[2 * 33], s[3 * 33]); o.z = pk2(s[4 * 33], s[5 * 33]); o.w = pk2(s[6 * 33], s[7 * 33]);
        const int nn = n0 + n; const int orow = ILV ? ((nn >> 7) * 256 + (nn & 127) + row_off) : (row_off + nn);
        *(GAS v4u*)(WT + (size_t)orow * K + k0 + 8 * c) = o; }
    LDS_WAIT(); asm volatile("" ::: "memory");
}

template <int ILV>
__device__ __forceinline__ void transpose_item_fp8(const float* W, int ldw, int K, int N, unsigned char* WT8, int row_off, LAS float* scr, int item, int lane, float scl) {
    const int nblk = N / 32, kb = item / nblk, nb = item % nblk, k0 = 64 * kb, n0 = 32 * nb;
    float wv_[32];
#pragma unroll
    for (int i = 0; i < 32; ++i) wv_[i] = W[(size_t)(k0 + 2 * i + (lane >> 5)) * ldw + n0 + (lane & 31)];
#pragma unroll
    for (int i = 0; i < 32; ++i) scr[(2 * i + (lane >> 5)) * 33 + (lane & 31)] = wv_[i] * scl;
    LDS_WAIT(); asm volatile("" ::: "memory");
    const int c = lane & 7;
#pragma unroll
    for (int j = 0; j < 4; ++j) { const int n = (lane >> 3) + 8 * j; const LAS float* s = scr + (8 * c) * 33 + n;
        v2u o; o.x = pk4_fp8(s[0 * 33], s[1 * 33], s[2 * 33], s[3 * 33]); o.y = pk4_fp8(s[4 * 33], s[5 * 33], s[6 * 33], s[7 * 33]);
        const int nn = n0 + n; const int orow = ILV ? ((nn >> 7) * 256 + (nn & 127) + row_off) : (row_off + nn);
        *(GAS v2u*)(WT8 + (size_t)orow * K + k0 + 8 * c) = o; }
    LDS_WAIT(); asm volatile("" ::: "memory");
}
__device__ __forceinline__ void rms_row(const float* xrow, const float* gain, int lane, float (&y)[16]) {
    const f32x4* xr = (const f32x4*)xrow + lane; const f32x4* gr = (const f32x4*)gain + lane;
    f32x4 v[4]; float s = 0.f;
#pragma unroll
    for (int j = 0; j < 4; ++j) { v[j] = xr[64 * j]; s += (v[j][0] * v[j][0] + v[j][1] * v[j][1]) + (v[j][2] * v[j][2] + v[j][3] * v[j][3]); }
    const float rstd = 1.f / sqrtf(wave_sum(s) * (1.f / D) + EPS);
#pragma unroll
    for (int j = 0; j < 4; ++j) { const f32x4 gg = gr[64 * j];
#pragma unroll
        for (int c = 0; c < 4; ++c) y[4 * j + c] = v[j][c] * rstd * gg[c]; }
}
__device__ __forceinline__ void row_load(const float* xrow, int lane, f32x4 (&v)[4]) { const f32x4* xr = (const f32x4*)xrow + lane;
#pragma unroll
    for (int j = 0; j < 4; ++j) v[j] = xr[64 * j]; }
__device__ __forceinline__ void rms_finish(const f32x4 (&v)[4], const float* gain, int lane, float (&y)[16]) { const f32x4* gr = (const f32x4*)gain + lane; float s = 0.f;
#pragma unroll
    for (int j = 0; j < 4; ++j) s += (v[j][0] * v[j][0] + v[j][1] * v[j][1]) + (v[j][2] * v[j][2] + v[j][3] * v[j][3]);
    const float rstd = __builtin_amdgcn_rsqf(wave_sum(s) * (1.f / D) + EPS);
#pragma unroll
    for (int j = 0; j < 4; ++j) { const f32x4 gg = gr[64 * j];
#pragma unroll
        for (int c = 0; c < 4; ++c) y[4 * j + c] = v[j][c] * rstd * gg[c]; } }
__device__ __forceinline__ void rms_finish_exact(const f32x4 (&v)[4], const float* gain, int lane, float (&y)[16]) { const f32x4* gr = (const f32x4*)gain + lane; float s = 0.f;
#pragma unroll
    for (int j = 0; j < 4; ++j) s += (v[j][0] * v[j][0] + v[j][1] * v[j][1]) + (v[j][2] * v[j][2] + v[j][3] * v[j][3]);
    const float rstd = 1.f / sqrtf(wave_sum(s) * (1.f / D) + EPS);
#pragma unroll
    for (int j = 0; j < 4; ++j) { const f32x4 gg = gr[64 * j];
#pragma unroll
        for (int c = 0; c < 4; ++c) y[4 * j + c] = v[j][c] * rstd * gg[c]; } }
__device__ __forceinline__ void store_row_bf16(bf16* orow, int lane, const float (&y)[16]) {
    unsigned long long* o8 = (unsigned long long*)orow + lane;
#pragma unroll
    for (int j = 0; j < 4; ++j) o8[64 * j] = (unsigned long long)pk2(y[4 * j], y[4 * j + 1]) | ((unsigned long long)pk2(y[4 * j + 2], y[4 * j + 3]) << 32);
}

__device__ __forceinline__ float sum4(float v) {
    v += __builtin_bit_cast(float, __builtin_amdgcn_update_dpp(0, __builtin_bit_cast(int, v), 0xB1, 0xf, 0xf, true));
    v += __builtin_bit_cast(float, __builtin_amdgcn_update_dpp(0, __builtin_bit_cast(int, v), 0x4E, 0xf, 0xf, true));
    return v;
}
__device__ __forceinline__ float sum8(float v) {
    v = sum4(v);
    v += __builtin_bit_cast(float, __builtin_amdgcn_update_dpp(0, __builtin_bit_cast(int, v), 0x141, 0xf, 0xf, true));
    return v;
}

__device__ __forceinline__ void phase_prologue(Frame& F) {
    int tz_ = F.wave * 64 + LANE_ID(); asm volatile("" : "+v"(tz_)); const int tid = tz_, lane = tz_ & 63, wave = __builtin_amdgcn_readfirstlane(tz_ >> 6); (void)tid; (void)lane; (void)wave;

    LAS float* scr = (LAS float*)(F.lds + wave * 8448);
    const int gw = F.vcu * 8 + wave, NGW = F.G * 8;
    bf16* WIN0 = (bf16*)(F.ws + WS_WIN0); bf16* WOUT0 = (bf16*)(F.ws + WS_WOUT0); bf16* W13 = (bf16*)(F.ws + WS_W13); bf16* W2 = (bf16*)(F.ws + WS_W2);
    bf16* WIN1 = (bf16*)(F.ws + WS_WIN1); bf16* WOUT1 = (bf16*)(F.ws + WS_WOUT1);
    constexpr int I_A = 16 * 112, I_B = 16 * 32, I_C = 16 * 88, I_D = 44 * 32, I_E = 16 * 128, I_F = 16 * 32;
    constexpr int NIT = I_A + I_B + 2 * I_C + I_D + I_E + I_F;
    int it = gw; const int nitw = (NIT - gw + NGW - 1) / NGW; int done = 0;
#define PR_ITEMS(upto) do { while (done < (upto) && it < NIT) { int r = it; \
        if (r < I_A) transpose_item<0>(F.in[I_EWIN], EIN, D, NPROJ0, WIN0, 0, scr, r, lane); \
        else if ((r -= I_A) < I_B) transpose_item<0>(F.in[I_EWOUT], D, D, D, WOUT0, 0, scr, r, lane); \
        else if ((r -= I_B) < I_C) transpose_item<1>(F.in[I_W1], DFF, D, DFF, W13, 0, scr, r, lane); \
        else if ((r -= I_C) < I_C) transpose_item<1>(F.in[I_W3], DFF, D, DFF, W13, 128, scr, r, lane); \
        else if ((r -= I_C) < I_D) transpose_item<0>(F.in[I_W2], D, DFF, D, W2, 0, scr, r, lane); \
        else if ((r -= I_D) < I_E) transpose_item<0>(F.in[I_OWIN], 4096, D, 4096, WIN1, 0, scr, r, lane); \
        else transpose_item<0>(F.in[I_OWOUT], D, D, D, WOUT1, 0, scr, r - I_E, lane); \
        it += NGW; ++done; } } while (0)
    LAS float* WsT = (LAS float*)(F.lds + 69632);
    for (int k = tid; k < D; k += 512) { const f32x4* p = (const f32x4*)(F.in[I_EWIN] + (size_t)k * EIN + NPROJ0); const f32x4 a = p[0], c = p[1];
        WsT[0 * D + k] = a[0]; WsT[1 * D + k] = a[1]; WsT[2 * D + k] = a[2]; WsT[3 * D + k] = a[3]; WsT[4 * D + k] = c[0]; WsT[5 * D + k] = c[1]; WsT[6 * D + k] = c[2]; WsT[7 * D + k] = c[3]; }
    __syncthreads();
    bf16* HN = (bf16*)(F.ws + WS_HN); float* BG = (float*)(F.ws + WS_BG);
    const float* gain = F.in[I_MIXN];
    float alog[4], dtb[4];
#pragma unroll
    for (int h = 0; h < 4; ++h) { alog[h] = F.in[I_BALOG][h]; dtb[h] = F.in[I_BDT][h]; }
    const float dtb_l = F.in[I_BDT][lane & 3], nega_l = -expf(F.in[I_BALOG][lane & 3]);
    int nrow_done = 0; const int nrows_w = (MROWS - gw + NGW - 1) / NGW;
    for (int r = gw; r < MROWS; r += NGW) {
        const float* src = (r < MR) ? F.in[I_X] + (size_t)r * D : F.in[I_META] + (size_t)((r - MR) & 15) * D;
        float y[16]; rms_row(src, gain, lane, y);
        store_row_bf16(HN + (size_t)r * D, lane, y);
        float d8[8];
#pragma unroll
        for (int j = 0; j < 8; ++j) { float s = 0.f;
#pragma unroll
            for (int jj = 0; jj < 4; ++jj) { const f32x4 w = *(const LAS f32x4*)(WsT + j * D + 4 * lane + 256 * jj); s += y[4 * jj] * w[0] + y[4 * jj + 1] * w[1] + y[4 * jj + 2] * w[2] + y[4 * jj + 3] * w[3]; }
            d8[j] = wave_sum(s); }
        {
            const int j8 = lane & 7; float dsel = d8[0];
#pragma unroll
            for (int k = 1; k < 8; ++k) dsel = (j8 == k) ? d8[k] : dsel;
            const float sg = 1.f / (1.f + expf(-dsel));
            const float xx = dsel + dtb_l; const float sp = fmaxf(xx, 0.f) + log1pf(expf(-fabsf(xx)));
            const float val = (j8 < 4) ? sg : nega_l * sp;
            if (lane < 8) BG[(size_t)prow_of_r(r) * 8 + lane] = val; }
        ++nrow_done; PR_ITEMS((nrow_done * nitw) / nrows_w);
    }
    PR_ITEMS(nitw);
#undef PR_ITEMS
}

__device__ __forceinline__ void qk_prep(Frame& F) {
    int tz_ = F.wave * 64 + LANE_ID(); asm volatile("" : "+v"(tz_)); const int tid = tz_, lane = tz_ & 63, wave = __builtin_amdgcn_readfirstlane(tz_ >> 6); (void)tid; (void)lane; (void)wave;

    const int gw = F.vcu * 8 + wave, NGW = F.G * 8;
    bf16* Q = (bf16*)(F.ws + WS_Q); bf16* K = (bf16*)(F.ws + WS_K);
    const int hc = lane >> 2, sub = lane & 3;
    float gn[16];
    { const float* gp = (hc < 8 ? F.in[I_AQG] : F.in[I_AKG]) + sub * 16;
#pragma unroll
      for (int i = 0; i < 16; ++i) gn[i] = gp[i]; }
    float invf[8];
#pragma unroll
    for (int i = 0; i < 8; ++i) invf[i] = powf(500000.0f, -(float)i * 0.125f);
    const float qscale = (hc < 8) ? 0.125f * 1.4426950408889634f : 1.0f;
    for (int idx = gw; idx < NB * LP; idx += NGW) {
        const int pp = idx % LP;
        bf16* rowp = (hc < 8 ? Q : K) + (size_t)idx * 512 + (hc & 7) * 64 + sub * 16;
        if (pp < 48) { *(v4u*)rowp = (v4u){0u, 0u, 0u, 0u}; *(v4u*)(rowp + 8) = (v4u){0u, 0u, 0u, 0u}; *(v4u*)((bf16*)(F.ws + WS_VR) + (size_t)idx * 512 + lane * 8) = (v4u){0u, 0u, 0u, 0u}; continue; }
        const v4u a = *(const v4u*)rowp, c = *(const v4u*)(rowp + 8);
        float x[16];
        x[0] = bflo(a.x); x[1] = bfhi(a.x); x[2] = bflo(a.y); x[3] = bfhi(a.y); x[4] = bflo(a.z); x[5] = bfhi(a.z); x[6] = bflo(a.w); x[7] = bfhi(a.w);
        x[8] = bflo(c.x); x[9] = bfhi(c.x); x[10] = bflo(c.y); x[11] = bfhi(c.y); x[12] = bflo(c.z); x[13] = bfhi(c.z); x[14] = bflo(c.w); x[15] = bfhi(c.w);
        float ss = 0.f;
#pragma unroll
        for (int i = 0; i < 16; ++i) ss += x[i] * x[i];
        ss = sum4(ss);
        const float rstd = 1.f / sqrtf(ss * (1.f / 64.f) + EPS);
#pragma unroll
        for (int i = 0; i < 16; ++i) x[i] = x[i] * rstd * gn[i];
        if (sub == 0) { const float pos = (float)(pp - 48);
#pragma unroll
            for (int i = 0; i < 8; ++i) { const float rev = __builtin_amdgcn_fractf(pos * invf[i] * 0.15915494309189535f);
                const float sn = __builtin_amdgcn_sinf(rev), cs = __builtin_amdgcn_cosf(rev); const float x1 = x[i], x2 = x[i + 8]; x[i] = x1 * cs - x2 * sn; x[i + 8] = x2 * cs + x1 * sn; } }
        v4u o0, o1;
        o0.x = pk2(x[0] * qscale, x[1] * qscale); o0.y = pk2(x[2] * qscale, x[3] * qscale); o0.z = pk2(x[4] * qscale, x[5] * qscale); o0.w = pk2(x[6] * qscale, x[7] * qscale);
        o1.x = pk2(x[8] * qscale, x[9] * qscale); o1.y = pk2(x[10] * qscale, x[11] * qscale); o1.z = pk2(x[12] * qscale, x[13] * qscale); o1.w = pk2(x[14] * qscale, x[15] * qscale);
        *(v4u*)rowp = o0; *(v4u*)(rowp + 8) = o1;
    }
}

__device__ __forceinline__ void v_transpose(Frame& F) {
    int tz_ = F.wave * 64 + LANE_ID(); asm volatile("" : "+v"(tz_)); const int tid = tz_, lane = tz_ & 63, wave = __builtin_amdgcn_readfirstlane(tz_ >> 6); (void)tid; (void)lane; (void)wave;

    const bf16* VR = (const bf16*)(F.ws + WS_VR); bf16* VT = (bf16*)(F.ws + WS_VT);
    constexpr int PITCH = 1040;
    for (int unit = F.vcu; unit < NB * NCH; unit += F.G) {
        const int b = unit / NCH, j = unit % NCH;
#pragma unroll
        for (int i = 0; i < 8; ++i) { const int id = tid + 512 * i, row = id >> 6, c8 = id & 63, pp = 64 * j + row;
            v4u v = *(const v4u*)(VR + (size_t)(b * LP + (pp < 48 ? 48 : pp)) * 512 + c8 * 8); if (pp < 48) v = (v4u){0u, 0u, 0u, 0u};
            *(LAS v4u*)(F.lds + row * PITCH + c8 * 16) = v; }
        __syncthreads();
        const int c = tid;
        unsigned w[32];
#pragma unroll
        for (int k = 0; k < 32; ++k) { const unsigned lo = *(const LAS unsigned short*)(F.lds + (2 * k) * PITCH + c * 2), hi = *(const LAS unsigned short*)(F.lds + (2 * k + 1) * PITCH + c * 2); w[k] = lo | (hi << 16); }
        bf16* dst = VT + ((size_t)(b * 4 + (c >> 7)) * 128 + (c & 127)) * LP + 64 * j;
#pragma unroll
        for (int k = 0; k < 8; ++k) *(v4u*)(dst + 8 * k) = (v4u){w[4 * k], w[4 * k + 1], w[4 * k + 2], w[4 * k + 3]};
        __syncthreads();
    }
}

__device__ __forceinline__ bf16x8 frag_nat(const LAS unsigned char* base, int rowbytes, int row, int quad, int ks) {
    return *(const LAS bf16x8*)(base + row * rowbytes + (32 * ks + 8 * quad) * 2);
}
__device__ __forceinline__ bf16x8 frag_pi(const LAS unsigned char* base, int rowbytes, int row, int quad, int ks) {
    const bf16x4 lo = *(const LAS bf16x4*)(base + row * rowbytes + (32 * ks + 4 * quad) * 2);
    const bf16x4 hi = *(const LAS bf16x4*)(base + row * rowbytes + (32 * ks + 16 + 4 * quad) * 2);
    return (bf16x8){lo[0], lo[1], lo[2], lo[3], hi[0], hi[1], hi[2], hi[3]};
}
__device__ __forceinline__ bf16x8 pack_tiles(const f32x4& a, const f32x4& b) {
    const v4u w = pack8(a, b); return __builtin_bit_cast(bf16x8, w);
}
__device__ __forceinline__ float row16_sum(float v) {
    v += __builtin_bit_cast(float, __builtin_amdgcn_update_dpp(0, __builtin_bit_cast(int, v), 0x128, 0xf, 0xf, true));
    v += __builtin_bit_cast(float, __builtin_amdgcn_update_dpp(0, __builtin_bit_cast(int, v), 0x124, 0xf, 0xf, true));
    v += __builtin_bit_cast(float, __builtin_amdgcn_update_dpp(0, __builtin_bit_cast(int, v), 0x122, 0xf, 0xf, true));
    v += __builtin_bit_cast(float, __builtin_amdgcn_update_dpp(0, __builtin_bit_cast(int, v), 0x121, 0xf, 0xf, true));
    return v;
}
#define SCHED_BAR() __builtin_amdgcn_sched_barrier(0)
#define MFMA16(a, b, c) __builtin_amdgcn_mfma_f32_16x16x32_bf16((a), (b), (c), 0, 0, 0)


template <class ZF, class OF, class VF>
__device__ __forceinline__ void post_tile(const int wv_, LAS unsigned char* L, const unsigned char* raw, const float* gain, ZF zrow, OF orow, VF ok,
                                          const bf16* cq = nullptr, const float* cdpre = nullptr, const bf16* csin = nullptr, gu32* qh = nullptr, volatile LAS unsigned* misc = nullptr) {
    int tz_ = wv_ * 64 + LANE_ID(); asm volatile("" : "+v"(tz_)); const int tid = tz_;
    unsigned popr = 0u; if (qh != nullptr && tid == 0) popr = __hip_atomic_fetch_add((unsigned*)qh, 1u, RLX_AGENT);
    LAS float* T = (LAS float*)L;
    const int c_ = tid >> 3, e16_ = (tid & 7) * 16;
    const bf16* zp_ = zrow(c_) + e16_; const v4u z0 = *(const v4u*)zp_, z1 = *(const v4u*)(zp_ + 8);
    f32x4 gq[4];
#pragma unroll
    for (int k = 0; k < 4; ++k) gq[k] = *(const f32x4*)(gain + e16_ + 4 * k);
#pragma unroll
    for (int i = 0; i < 4; ++i) { const int gid = tid + 512 * i, wv = gid >> 8, rb = (gid >> 6) & 3, ln = gid & 63, q4 = ln >> 4, col = ln & 15;
        const v2u w = *(const v2u*)(raw + (size_t)gid * 8); LAS float* d = T + (16 * rb + 4 * q4) * 132 + 16 * wv + col;
        d[0] = bflo(w.x); d[132] = bfhi(w.x); d[264] = bflo(w.y); d[396] = bfhi(w.y); }
    if (cq) {
        LAS unsigned char* QT = L + 33792; LAS unsigned char* ST = L + 51200;
#pragma unroll
        for (int i = 0; i < 2; ++i) { const int id = tid + 512 * i, row = id >> 4, c16 = id & 15; const v4u q = *(const v4u*)(cq + (size_t)id * 8);
            const f32x4 d0 = *(const f32x4*)(cdpre + 8 * c16), d1 = *(const f32x4*)(cdpre + 8 * c16 + 4);
            *(LAS v4u*)(QT + row * 272 + c16 * 16) = (v4u){pk2(bflo(q.x) * d0[0], bfhi(q.x) * d0[1]), pk2(bflo(q.y) * d0[2], bfhi(q.y) * d0[3]), pk2(bflo(q.z) * d1[0], bfhi(q.z) * d1[1]), pk2(bflo(q.w) * d1[2], bfhi(q.w) * d1[3])}; }
        if (csin) {
#pragma unroll
            for (int i = 0; i < 4; ++i) { const int id = tid + 512 * i, row = id >> 4, c16 = id & 15; *(LAS v4u*)(ST + row * 272 + c16 * 16) = *(const v4u*)(csin + (size_t)id * 8); }
        }
        __syncthreads();
        const int lane = tid & 63, nb = __builtin_amdgcn_readfirstlane(tid >> 6), row = lane & 15, quad = lane >> 4;
        bf16x8 bs[4];
#pragma unroll
        for (int ks = 0; ks < 4; ++ks) bs[ks] = frag_nat(ST, 272, 16 * nb + row, quad, ks);
#pragma unroll
        for (int rb = 0; rb < 4; ++rb) { f32x4 acc = (f32x4){0.f, 0.f, 0.f, 0.f};
#pragma unroll
            for (int ks = 0; ks < 4; ++ks) acc = MFMA16(frag_nat(QT, 272, 16 * rb + row, quad, ks), bs[ks], acc);
            LAS float* d = T + (16 * rb + 4 * quad) * 132 + 16 * nb + row; d[0] += acc[0]; d[132] += acc[1]; d[264] += acc[2]; d[396] += acc[3]; }
    }
    if (qh != nullptr && tid == 0) misc[6] = popr;
    __syncthreads();
    {   const int c = c_, e16 = e16_;
        float v[16]; float ss = 0.f;
#pragma unroll
        for (int k = 0; k < 4; ++k) { const f32x4 x = *(const LAS f32x4*)(T + c * 132 + e16 + 4 * k); v[4 * k] = x[0]; v[4 * k + 1] = x[1]; v[4 * k + 2] = x[2]; v[4 * k + 3] = x[3];
            ss += (x[0] * x[0] + x[1] * x[1]) + (x[2] * x[2] + x[3] * x[3]); }
        ss = sum8(ss);
        const float rstd = 1.f / sqrtf(ss * (1.f / 128.f) + EPS);
        const unsigned zw[8] = {z0.x, z0.y, z0.z, z0.w, z1.x, z1.y, z1.z, z1.w};
        unsigned ow[8];
#pragma unroll
        for (int k = 0; k < 8; ++k) { const float g0 = gq[k >> 1][(k & 1) * 2], g1 = gq[k >> 1][(k & 1) * 2 + 1];
            ow[k] = pk2(v[2 * k] * rstd * g0 * siluf_(bflo(zw[k])), v[2 * k + 1] * rstd * g1 * siluf_(bfhi(zw[k]))); }
        if (ok(c)) { bf16* op = orow(c) + e16; *(v4u*)op = (v4u){ow[0], ow[1], ow[2], ow[3]}; *(v4u*)(op + 8) = (v4u){ow[4], ow[5], ow[6], ow[7]}; }
    }
    __syncthreads();
}

constexpr int DP_QS = 0, DP_KS = 17408, DP_VT = 34816, DP_KGT = 53248, DP_KT = 71680, DP_MS = 90112, DP_TS = 107520, DP_GC = 116736, DP_BETA = 116992, DP_CW = 117248, DP_X = 133120, DP_P = 150528;
constexpr int DP_SQ = 90112, DP_SK = 133120, DP_SVA = 108336, DP_SVB = 151344, DP_SV_SPLIT = 30;
static_assert(DP_SVA + DP_SV_SPLIT * 272 <= 116736 && DP_SVB + (67 - DP_SV_SPLIT) * 272 <= LDS_BYTES && DP_SK + 67 * 272 <= DP_SVB && DP_P + 4352 <= LDS_BYTES, "dn_prep staging map");
__device__ __forceinline__ int dp_stage_off(int g, int srow) { return g == 0 ? DP_SQ + srow * 272 : g == 1 ? DP_SK + srow * 272 : (srow < DP_SV_SPLIT ? DP_SVA + srow * 272 : DP_SVB + (srow - DP_SV_SPLIT) * 272); }
__device__ __forceinline__ void dn_prep_unit(Frame& F, int b, int h, int n) {
    LAS unsigned char* L = F.lds;
    int tz = F.wave * 64 + LANE_ID(); asm volatile("" : "+v"(tz));
    const int tid = tz, lane = tz & 63, wave = __builtin_amdgcn_readfirstlane(tz >> 6);
    const bf16* CR = (const bf16*)(F.ws + WS_CRAW); const float* BG = (const float*)(F.ws + WS_BG);
    unsigned char* blob = F.ws + WS_SCAN0 + (size_t)((b * 4 + h) * NCH + n) * DN_BLOB;
    LAS float* GCs = (LAS float*)(L + DP_GC); LAS float* BETAs = (LAS float*)(L + DP_BETA); LAS float* CW = (LAS float*)(L + DP_CW);
    if (tid < 64) { const int pp = 64 * n + tid; float be = 0.f, g = 0.f;
        if (pp >= 48) { const float* p = BG + (size_t)(b * LP + pp) * 8; be = p[h]; g = p[4 + h]; }
#pragma unroll
        for (int o = 1; o < 64; o <<= 1) { const float t = __shfl_up(g, o); if (lane >= o) g += t; }
        GCs[tid] = g; BETAs[tid] = be; *(float*)(blob + DN_GC + tid * 4) = g; }
    for (int idx = tid; idx < 4 * 384; idx += 512) { const int j = idx / 384, c = idx % 384; CW[idx] = F.in[I_BCONV][j * 1536 + (c >> 7) * 512 + h * 128 + (c & 127)]; }
#pragma unroll
    for (int i = 0; i < 7; ++i) { const int idx0 = tid + 512 * i, idx = idx0 < 67 * 48 ? idx0 : 67 * 48 - 1; { const int srow = idx / 48, rem = idx % 48, g = rem >> 4, ch = rem & 15; const int ppj = 64 * n - 3 + srow;
            v4u x = *(const v4u*)(CR + (size_t)(b * LP + (ppj < 48 ? 48 : ppj)) * 1536 + g * 512 + h * 128 + ch * 8); if (ppj < 48) x = (v4u){0u, 0u, 0u, 0u};
            *(LAS v4u*)(L + dp_stage_off(g, srow) + ch * 16) = x; } }
    __syncthreads();
    {
        const int i = tid >> 3, part = tid & 7;
        const float be = BETAs[i], eg = fast_exp(GCs[i]);
#pragma unroll 1
        for (int g = 0; g < 3; ++g) {
            float a[16];
#pragma unroll
            for (int c = 0; c < 16; ++c) a[c] = 0.f;
#pragma unroll
            for (int j = 0; j < 4; ++j) { const LAS unsigned char* stg = L + dp_stage_off(g, i + j) + part * 32; const v4u x0 = *(const LAS v4u*)stg, x1 = *(const LAS v4u*)(stg + 16);
                const LAS float* w = CW + j * 384 + g * 128 + part * 16;
                a[0] += w[0] * bflo(x0.x); a[1] += w[1] * bfhi(x0.x); a[2] += w[2] * bflo(x0.y); a[3] += w[3] * bfhi(x0.y);
                a[4] += w[4] * bflo(x0.z); a[5] += w[5] * bfhi(x0.z); a[6] += w[6] * bflo(x0.w); a[7] += w[7] * bfhi(x0.w);
                a[8] += w[8] * bflo(x1.x); a[9] += w[9] * bfhi(x1.x); a[10] += w[10] * bflo(x1.y); a[11] += w[11] * bfhi(x1.y);
                a[12] += w[12] * bflo(x1.z); a[13] += w[13] * bfhi(x1.z); a[14] += w[14] * bflo(x1.w); a[15] += w[15] * bfhi(x1.w); }
            float ss = 0.f;
#pragma unroll
            for (int c = 0; c < 16; ++c) { a[c] = siluf_(a[c]); ss += a[c] * a[c]; }
            ss = sum8(ss);
            float sc = 1.f / sqrtf(ss + EPS);
            if (g == 0) sc *= 0.08838834764831845f; else if (g == 2) sc = be;
#pragma unroll
            for (int c = 0; c < 16; ++c) a[c] *= sc;
            if (g < 2) {
                const v4u p0 = (v4u){pk2(a[0], a[1]), pk2(a[2], a[3]), pk2(a[4], a[5]), pk2(a[6], a[7])}, p1 = (v4u){pk2(a[8], a[9]), pk2(a[10], a[11]), pk2(a[12], a[13]), pk2(a[14], a[15])};
                const int off = (g == 0) ? DP_QS : DP_KS;
                *(LAS v4u*)(L + off + i * 272 + part * 32) = p0; *(LAS v4u*)(L + off + i * 272 + part * 32 + 16) = p1;
                if (g == 0) { *(v4u*)(blob + DN_Q + (i * 128 + part * 16) * 2) = p0; *(v4u*)(blob + DN_Q + (i * 128 + part * 16) * 2 + 16) = p1; }
            }
            if (g == 1) {
#pragma unroll
                for (int c = 0; c < 16; ++c) { const int ch = part * 16 + c;
                    *(LAS bf16*)(L + DP_KT + ch * 144 + i * 2) = f2bf(a[c]);
                    *(LAS bf16*)(L + DP_KGT + ch * 144 + i * 2) = f2bf(be * a[c] * eg); }
            }
            if (g == 2) {
#pragma unroll
                for (int c = 0; c < 16; ++c) *(LAS bf16*)(L + DP_VT + (part * 16 + c) * 144 + i * 2) = f2bf(a[c]);
            }
        }
    }
    __syncthreads();
    {
        const int row = lane & 15, quad = lane >> 4, ib = wave & 3; const bool isqk = wave >= 4;
        const LAS unsigned char* Abase = L + (isqk ? DP_QS : DP_KS);
        bf16x8 af[4];
#pragma unroll
        for (int ks = 0; ks < 4; ++ks) af[ks] = frag_nat(Abase, 272, 16 * ib + row, quad, ks);
        LAS float* MS = (LAS float*)(L + DP_MS);
#pragma unroll
        for (int jb = 0; jb < 4; ++jb) {
            f32x4 acc = (f32x4){0.f, 0.f, 0.f, 0.f};
            if (jb <= ib) {
#pragma unroll
                for (int ks = 0; ks < 4; ++ks) acc = MFMA16(af[ks], frag_nat(L + DP_KS, 272, 16 * jb + row, quad, ks), acc);
            }
            const int j = 16 * jb + row; const float gj = GCs[j];
#pragma unroll
            for (int r = 0; r < 4; ++r) { const int i = 16 * ib + 4 * quad + r; const float dec = fast_exp(GCs[i] - gj);
                if (isqk) { const float v = (j <= i) ? acc[r] * dec : 0.f; *(bf16*)(blob + DN_QK + (i * 64 + j) * 2) = f2bf(v); }
                else { const float v = (j < i) ? BETAs[i] * acc[r] * dec : 0.f; MS[i * 68 + j] = v; } }
        }
    }
    __syncthreads();
    {
        int zo = 0; asm volatile("" : "+v"(zo));
        const LAS float* MS = (const LAS float*)(L + DP_MS) + zo; LAS float* X = (LAS float*)(L + DP_X) + zo; LAS float* P = (LAS float*)(L + DP_P) + zo;
        if (wave < 4) {
            const int c = lane & 15, o = 16 * wave; float t[16];
#pragma unroll
            for (int i = 0; i < 16; ++i) { float acc = (c == i) ? 1.f : 0.f;
#pragma unroll
                for (int j4 = 0; j4 < (i + 3) / 4; ++j4) { const f32x4 mv = *(const LAS f32x4*)(MS + (o + i) * 68 + o + 4 * j4);
#pragma unroll
                    for (int q = 0; q < 4; ++q) if (4 * j4 + q < i) acc -= mv[q] * t[4 * j4 + q]; }
                t[i] = acc; }
            if (lane < 16) {
#pragma unroll
                for (int i = 0; i < 16; ++i) X[(o + i) * 68 + o + c] = t[i]; }
        } else {
            const int w2 = wave - 4, blk = w2 >> 1, hl = w2 & 1;
#pragma unroll
            for (int q = 0; q < 2; ++q) { const int id = hl * 128 + q * 64 + lane, r = id >> 4, cc = id & 15; X[(32 * blk + r) * 68 + 32 * blk + 16 + cc] = 0.f; }
        }
        __syncthreads();
        {
            const int blk = tid >> 8, r = (tid >> 4) & 15, c = tid & 15, R0 = 32 * blk + 16, C0 = 32 * blk;
            float acc = 0.f;
#pragma unroll
            for (int k = 0; k < 16; ++k) acc += MS[(R0 + r) * 68 + C0 + k] * X[(C0 + k) * 68 + C0 + c];
            P[blk * 272 + r * 17 + c] = acc;
            __syncthreads();
            float o2 = 0.f;
#pragma unroll
            for (int k = 0; k < 16; ++k) o2 -= X[(R0 + r) * 68 + R0 + k] * P[blk * 272 + k * 17 + c];
            X[(R0 + r) * 68 + C0 + c] = o2;
        }
        __syncthreads();
        {
            const int r = tid >> 4, c0 = (tid & 15) * 2;
            float a0 = 0.f, a1 = 0.f;
#pragma unroll
            for (int k = 0; k < 32; ++k) { const float m = MS[(32 + r) * 68 + k]; a0 += m * X[k * 68 + c0]; a1 += m * X[k * 68 + c0 + 1]; }
            P[r * 34 + c0] = a0; P[r * 34 + c0 + 1] = a1;
            __syncthreads();
            float o0 = 0.f, o1 = 0.f;
#pragma unroll
            for (int k = 0; k < 32; ++k) { const float x = X[(32 + r) * 68 + 32 + k]; o0 -= x * P[k * 34 + c0]; o1 -= x * P[k * 34 + c0 + 1]; }
            X[(32 + r) * 68 + c0] = o0; X[(32 + r) * 68 + c0 + 1] = o1;
        }
        __syncthreads();
        {
            const int i = tid >> 3, c8 = (tid & 7) * 8; float v[8];
#pragma unroll
            for (int q = 0; q < 8; ++q) v[q] = ((c8 >> 4) > (i >> 4)) ? 0.f : X[i * 68 + c8 + q];
            *(LAS v4u*)(L + DP_TS + i * 144 + c8 * 2) = (v4u){pk2(v[0], v[1]), pk2(v[2], v[3]), pk2(v[4], v[5]), pk2(v[6], v[7])};
        }
    }
    __syncthreads();
    {
        const int row = lane & 15, quad = lane >> 4, nb = wave;
        bf16x8 bv[2], bk[2];
#pragma unroll
        for (int ks = 0; ks < 2; ++ks) { bv[ks] = frag_nat(L + DP_VT, 144, 16 * nb + row, quad, ks); bk[ks] = frag_nat(L + DP_KGT, 144, 16 * nb + row, quad, ks); }
#pragma unroll
        for (int rb = 0; rb < 4; ++rb) {
            f32x4 au = (f32x4){0.f, 0.f, 0.f, 0.f}, aw = (f32x4){0.f, 0.f, 0.f, 0.f};
#pragma unroll
            for (int ks = 0; ks < 2; ++ks) { const bf16x8 a = frag_nat(L + DP_TS, 144, 16 * rb + row, quad, ks); au = MFMA16(a, bv[ks], au); aw = MFMA16(a, bk[ks], aw); }
            *(v2u*)(blob + DN_U + (size_t)(((nb * 4 + rb) * 64 + lane) * 4) * 2) = (v2u){pk2(au[0], au[1]), pk2(au[2], au[3])};
#pragma unroll
            for (int r = 0; r < 4; ++r) *(bf16*)(blob + DN_W + ((16 * rb + 4 * quad + r) * 128 + 16 * nb + row) * 2) = f2bf(aw[r]);
        }
#pragma unroll
        for (int i = 0; i < 2; ++i) { const int id = tid + 512 * i, rr = id >> 3, c = id & 7; *(v4u*)(blob + DN_KT + (rr * 64 + c * 8) * 2) = *(const LAS v4u*)(L + DP_KT + rr * 144 + c * 16); }
    }
    __syncthreads();
}
__device__ __forceinline__ void phase_prep0(Frame& F, bool with_qk) {
    for (int unit = F.vcu; unit < NB * 4 * NCH; unit += F.G) { const int bh = unit / NCH, n = unit % NCH; dn_prep_unit(F, bh >> 2, bh & 3, n); }
    if (with_qk) qk_prep(F);
}

__device__ __forceinline__ float swap32_max(float v) { auto rr = __builtin_amdgcn_permlane32_swap(__float_as_uint(v), __float_as_uint(v), false, false); return fmaxf(__uint_as_float(rr[0]), __uint_as_float(rr[1])); }
__device__ __forceinline__ float swap32_sum(float v) { auto rr = __builtin_amdgcn_permlane32_swap(__float_as_uint(v), __float_as_uint(v), false, false); return __uint_as_float(rr[0]) + __uint_as_float(rr[1]); }
#define MFMA32(a, b, c) __builtin_amdgcn_mfma_f32_32x32x16_bf16((a), (b), (c), 0, 0, 0)

__device__ __forceinline__ void glds16(const void* gsrc, unsigned lds_dst) { unsigned keep;
    asm volatile("s_mov_b32 %0, m0\n\ts_mov_b32 m0, %2\n\ts_nop 0\n\tglobal_load_lds_dwordx4 %1, off\n\ts_mov_b32 m0, %0" : "=&s"(keep) : "v"(gsrc), "s"(lds_dst) : "memory"); }
__device__ __forceinline__ void glds16s(const void* sbase, unsigned voff, unsigned lds_dst) { unsigned keep;
    asm volatile("s_mov_b32 %0, m0\n\ts_mov_b32 m0, %3\n\ts_nop 0\n\tglobal_load_lds_dwordx4 %1, %2\n\ts_mov_b32 m0, %0" : "=&s"(keep) : "v"(voff), "s"(sbase), "s"(lds_dst) : "memory"); }
constexpr float AT_THR = 6.f;
constexpr int AT_K0 = 0, AT_K1 = 8192, AT_VT = 16384, AT_STAGE = 32768, AT_NST = 4;
__device__ __forceinline__ void attn_unit(Frame& F, int b, int h, int cb) {
    LAS unsigned char* L = F.lds;
    int tz = F.wave * 64 + LANE_ID(); asm volatile("" : "+v"(tz));
    const int tid = tz, lane = tz & 63, wave = __builtin_amdgcn_readfirstlane(tz >> 6);
    const int comp = wave >> 2, wq = wave & 3, m = lane & 31, hh = lane >> 5;
    const bf16* Qb = (const bf16*)(F.ws + WS_Q); const bf16* Kb = (const bf16*)(F.ws + WS_K); const bf16* VRb = (const bf16*)(F.ws + WS_VR); bf16* Ob = (bf16*)(F.ws + WS_O);
    const int pq = 64 * cb + 32 * wq + m; const bool valid = pq >= 48; const int pc = pq < 48 ? 48 : pq;
    bf16x8 qf[4];
    { const bf16* qsrc = Qb + (size_t)(b * LP + pc) * 512 + (2 * h + comp) * 64 + 8 * hh;
#pragma unroll
      for (int d0 = 0; d0 < 4; ++d0) qf[d0] = *(const bf16x8*)(qsrc + 16 * d0);
      asm volatile("" : "+v"(qf[0]), "+v"(qf[1]), "+v"(qf[2]), "+v"(qf[3])); }
    const int chunk_w = cb + (wq >> 1); const int ntw = chunk_w + 1, nt = cb + 2;
    const int prow = lane >> 3, ppos = lane & 7;
    const int krow = 8 * wave + prow, kch = ppos ^ ((krow >> 1) & 7);
    const unsigned kvo = (unsigned)(krow * 1024 + kch * 16);
    const int vrow0 = 8 * (wave >> 1) + ((lane >> 2) & 7), vch0 = 4 * (2 * (wave & 1) + (lane >> 5)) + ((lane & 3) ^ ((vrow0 >> 2) & 3));
    const unsigned vvo = (unsigned)(vrow0 * 1024 + vch0 * 16);
    const int bu = __builtin_amdgcn_readfirstlane(b), hu = __builtin_amdgcn_readfirstlane(h);
    const bf16* kgu = Kb + (size_t)(bu * LP) * 512 + (2 * hu) * 64;
    const bf16* vgu = VRb + (size_t)(bu * LP) * 512 + hu * 128;
    const unsigned pbase = (unsigned)wave * 1024u;
    const unsigned lds0 = (unsigned)(size_t)L;
#define AT_DMA_K(tt, st) do { const unsigned S_ = (unsigned)__builtin_amdgcn_readfirstlane((int)(lds0 + (st) * AT_STAGE + pbase)); \
        glds16s(kgu + (size_t)(tt) * 64 * 512, kvo, S_ + AT_K0); glds16s(kgu + (size_t)(tt) * 64 * 512 + 64, kvo, S_ + AT_K1); } while (0)
#define AT_DMA_V(tt, st) do { const unsigned S_ = (unsigned)__builtin_amdgcn_readfirstlane((int)(lds0 + (st) * AT_STAGE + pbase)); \
        glds16s(vgu + (size_t)(tt) * 64 * 512, vvo, S_ + AT_VT); glds16s(vgu + (size_t)(tt) * 64 * 512 + (size_t)32 * 512, vvo, S_ + AT_VT + 8192); } while (0)
    const int sig = (m & ~12) | ((m & 4) << 1) | ((m & 8) >> 1);
    const int kbase = comp * AT_K1 + sig * 128 + hh * 16, kkey = ((sig >> 1) & 7) * 16;
    AT_DMA_K(0, 0); AT_DMA_V(0, 0); if (1 < nt) { AT_DMA_K(1, 1); AT_DMA_V(1, 1); } if (2 < nt) AT_DMA_K(2, 2);
    if (2 < nt) asm volatile("s_waitcnt vmcnt(8)" ::: "memory"); else if (1 < nt) asm volatile("s_waitcnt vmcnt(6)" ::: "memory"); else asm volatile("s_waitcnt vmcnt(2)" ::: "memory");
    __builtin_amdgcn_s_barrier();
    f32x16 o[4];
#pragma unroll
    for (int d = 0; d < 4; ++d)
#pragma unroll
        for (int i = 0; i < 16; ++i) o[d][i] = 0.f;
    float mrun = 0.f, lrun = 0.f, alpha = 1.f; bool resc = false;
    f32x16 pA0, pA1, pB0, pB1;
    f32x16 negm;
#pragma unroll
    for (int i = 0; i < 16; ++i) { negm[i] = 0.f; pA0[i] = 0.f; pA1[i] = 0.f; pB0[i] = 0.f; pB1[i] = 0.f; }
    int kx[4];
#pragma unroll
    for (int j = 0; j < 4; ++j) kx[j] = (kbase + j * 32) ^ kkey;
    int vb0, vb1;
    { const int g = lane >> 4, gb = g & 1, q = (lane >> 2) & 3, p = lane & 3, cl = 2 * gb + (p >> 1);
      vb0 = AT_VT + 2048 * hh + 64 * q + 16 * (cl ^ ((2 * hh) & 3)) + 8 * (p & 1);
      vb1 = AT_VT + 2048 * hh + 64 * q + 16 * (cl ^ ((2 * hh + 1) & 3)) + 8 * (p & 1) + 256; }
    bf16x8 kf0 = qf[0], kf1 = qf[0], vf0 = qf[0], vf1 = qf[0], vf2 = qf[0];
#define AT_PIN(x) asm volatile("" : "+v"(x))
#define AT_KF(i) (*(const LAS bf16x8*)(Ls + kx[(i) >> 1] + ((i) & 1) * (32 * 128)))
#define AT_TR(p_) __builtin_amdgcn_ds_read_tr16_b64_v4i16((LAS s16x4_t*)(p_))
#define AT_VF(i) ({ const s16x4_t a_ = AT_TR(Lv + vb0 + 4096 * ((i) & 3) + 512 * ((i) >> 2)), b_ = AT_TR(Lv + vb1 + 4096 * ((i) & 3) + 512 * ((i) >> 2)); (bf16x8){a_[0], a_[1], a_[2], a_[3], b_[0], b_[1], b_[2], b_[3]}; })
#define AT_YV(Y0, Y1, j) ((j) < 16 ? Y0[(j) & 15] : Y1[(j) & 15])
#define AT_PB(Y0, s) __builtin_bit_cast(bf16x8, (f32x4){Y0[4 * (s)], Y0[4 * (s) + 1], Y0[4 * (s) + 2], Y0[4 * (s) + 3]})
#define AT_ISSUE(tt) do { if ((tt) + 3 < nt) AT_DMA_K((tt) + 3, ((tt) + 3) % AT_NST); if ((tt) + 2 < nt) AT_DMA_V((tt) + 2, ((tt) + 2) % AT_NST); } while (0)
#define AT_CLOSE(tt) do { const int rem_ = nt - (tt); \
        if (rem_ > 3) asm volatile("s_waitcnt vmcnt(8) lgkmcnt(0)" ::: "memory"); else if (rem_ == 3) asm volatile("s_waitcnt vmcnt(6) lgkmcnt(0)" ::: "memory"); \
        else if (rem_ == 2) asm volatile("s_waitcnt vmcnt(2) lgkmcnt(0)" ::: "memory"); else asm volatile("s_waitcnt vmcnt(0) lgkmcnt(0)" ::: "memory"); \
        __builtin_amdgcn_s_barrier(); } while (0)
#define AT_ROWMAX(X0, X1, mx) do { float a_ = fmaxf(fmaxf(X0[0], X0[1]), X1[0]), b_ = fmaxf(fmaxf(X0[2], X0[3]), X1[1]); a_ = fmaxf(fmaxf(a_, X1[2]), X1[3]); \
        _Pragma("unroll") for (int r = 4; r < 16; r += 4) { a_ = fmaxf(fmaxf(a_, X0[r]), X0[r + 1]); b_ = fmaxf(fmaxf(b_, X0[r + 2]), X0[r + 3]); a_ = fmaxf(fmaxf(a_, X1[r]), X1[r + 1]); b_ = fmaxf(fmaxf(b_, X1[r + 2]), X1[r + 3]); } \
        mx = swap32_max(fmaxf(a_, b_)); } while (0)
#define AT_SUMPACK(Y0, Y1) do { float sacc = 0.f; \
        _Pragma("unroll") for (int w = 0; w < 16; ++w) { sacc += AT_YV(Y0, Y1, 2 * w); sacc += AT_YV(Y0, Y1, 2 * w + 1); \
            const unsigned v_ = pk2(AT_YV(Y0, Y1, 2 * w), AT_YV(Y0, Y1, 2 * w + 1)); Y0[w] = __uint_as_float(v_); AT_PIN(Y0); AT_PIN(sacc); } \
        lrun += sacc; } while (0)
#define AT_PV(Y0, tt) do { const LAS unsigned char* Lv = L + (((tt) + AT_NST) % AT_NST) * AT_STAGE; \
        vf0 = AT_VF(0); vf1 = AT_VF(1); vf2 = AT_VF(2); \
        _Pragma("unroll") for (int i = 0; i < 16; ++i) { const bf16x8 c_ = vf0; vf0 = vf1; vf1 = vf2; if (i + 3 < 16) vf2 = AT_VF(i + 3); \
            o[i >> 2] = MFMA32(c_, AT_PB(Y0, i & 3), o[i >> 2]); SCHED_BAR(); } } while (0)
#define AT_XV(X0, X1, j) ((j) < 16 ? X0[(j) & 15] : X1[(j) & 15])
#define AT_EXP1(X0, X1, j) do { if ((j) < 16) X0[(j) & 15] = __builtin_amdgcn_exp2f(X0[(j) & 15]); else X1[(j) & 15] = __builtin_amdgcn_exp2f(X1[(j) & 15]); } while (0)
#define AT_STEP(X0, X1, Y0, Y1, tt) do { \
        const LAS unsigned char* Ls = L + ((tt) % AT_NST) * AT_STAGE; const LAS unsigned char* Lv = L + (((tt) + AT_NST - 1) % AT_NST) * AT_STAGE; \
        kf0 = AT_KF(0); kf1 = AT_KF(1); \
        const bool dk_ = (tt) + 3 < nt, dv_ = (tt) + 2 < nt; \
        const unsigned SK_ = (unsigned)__builtin_amdgcn_readfirstlane((int)(lds0 + (((tt) + 3) % AT_NST) * AT_STAGE + pbase)), SV_ = (unsigned)__builtin_amdgcn_readfirstlane((int)(lds0 + (((tt) + 2) % AT_NST) * AT_STAGE + pbase)); \
        float sacc = 0.f; SCHED_BAR(); \
        _Pragma("unroll") for (int i = 0; i < 8; ++i) { \
            const bf16x8 c_ = kf0; kf0 = kf1; if (i + 2 < 8) kf1 = AT_KF(i + 2); \
            if (i == 5) vf0 = AT_VF(0); if (i == 6) vf1 = AT_VF(1); if (i == 7) vf2 = AT_VF(2); \
            if (i == 0) X0 = MFMA32(c_, qf[0], negm); else if (i == 1) X1 = MFMA32(c_, qf[0], negm); else if (i & 1) X1 = MFMA32(c_, qf[i >> 1], X1); else X0 = MFMA32(c_, qf[i >> 1], X0); \
            sacc += AT_YV(Y0, Y1, 4 * i); sacc += AT_YV(Y0, Y1, 4 * i + 1); sacc += AT_YV(Y0, Y1, 4 * i + 2); sacc += AT_YV(Y0, Y1, 4 * i + 3); \
            { const unsigned v0_ = pk2(AT_YV(Y0, Y1, 4 * i), AT_YV(Y0, Y1, 4 * i + 1)), v1_ = pk2(AT_YV(Y0, Y1, 4 * i + 2), AT_YV(Y0, Y1, 4 * i + 3)); Y0[2 * i] = __uint_as_float(v0_); Y0[2 * i + 1] = __uint_as_float(v1_); } \
            AT_PIN(Y0); AT_PIN(sacc); SCHED_BAR(); } \
        lrun += sacc; resc = false; \
        float ma_ = -INFINITY, mb_ = -INFINITY; \
        _Pragma("unroll") for (int i = 0; i < 16; ++i) { const bf16x8 c_ = vf0; vf0 = vf1; vf1 = vf2; if (i + 3 < 16) vf2 = AT_VF(i + 3); \
            o[i >> 2] = MFMA32(c_, AT_PB(Y0, i & 3), o[i >> 2]); \
            if (i < 4) {   \
                ma_ = fmaxf(fmaxf(ma_, X0[4 * i]), X0[4 * i + 1]); mb_ = fmaxf(fmaxf(mb_, X0[4 * i + 2]), X0[4 * i + 3]); ma_ = fmaxf(fmaxf(ma_, X1[4 * i]), X1[4 * i + 1]); mb_ = fmaxf(fmaxf(mb_, X1[4 * i + 2]), X1[4 * i + 3]); \
                AT_PIN(ma_); AT_PIN(mb_); \
                if (i == 0 && dk_) glds16s(kgu + (size_t)((tt) + 3) * 64 * 512, kvo, SK_ + AT_K0); if (i == 1 && dk_) glds16s(kgu + (size_t)((tt) + 3) * 64 * 512 + 64, kvo, SK_ + AT_K1); \
                if (i == 2 && dv_) glds16s(vgu + (size_t)((tt) + 2) * 64 * 512, vvo, SV_ + AT_VT); if (i == 3 && dv_) glds16s(vgu + (size_t)((tt) + 2) * 64 * 512 + (size_t)32 * 512, vvo, SV_ + AT_VT + 8192); \
                if (i == 3) { const float mx = swap32_max(fmaxf(ma_, mb_)); \
                    if (__builtin_expect(__builtin_amdgcn_ballot_w64(mx > AT_THR) != 0ull, 0)) { const float dl = fmaxf(mx, 0.f); mrun += dl; alpha = __builtin_amdgcn_exp2f(-dl); lrun *= alpha; \
                        _Pragma("unroll") for (int r = 0; r < 16; ++r) { X0[r] -= dl; X1[r] -= dl; negm[r] = -mrun; } resc = true; } } \
            } else { const int k_ = i - 4, lo_ = (k_ * 8) / 3, hi_ = ((k_ + 1) * 8) / 3; \
                AT_EXP1(X0, X1, lo_); AT_EXP1(X0, X1, lo_ + 1); if (hi_ - lo_ == 3) AT_EXP1(X0, X1, lo_ + 2); \
                if (lo_ < 16) AT_PIN(X0); if (hi_ > 16) AT_PIN(X1); } \
            SCHED_BAR(); } \
        if (resc) { _Pragma("unroll") for (int d = 0; d < 4; ++d) _Pragma("unroll") for (int i = 0; i < 16; ++i) o[d][i] *= alpha; } \
    } while (0)
    if (ntw >= 1) {
        const LAS unsigned char* Ls = L;
        AT_ISSUE(0);
#pragma unroll
        for (int i = 0; i < 8; ++i) { const bf16x8 c_ = AT_KF(i);
            if (i == 0) pA0 = MFMA32(c_, qf[0], negm); else if (i == 1) pA1 = MFMA32(c_, qf[0], negm); else if (i & 1) pA1 = MFMA32(c_, qf[i >> 1], pA1); else pA0 = MFMA32(c_, qf[i >> 1], pA0); }
#pragma unroll
        for (int i = 0; i < 16; ++i) pA0[i] = -INFINITY;
#pragma unroll
        for (int i = 0; i < 8; ++i) pA1[i] = -INFINITY;
        float mx = fmaxf(fmaxf(pA1[8], pA1[9]), fmaxf(pA1[10], pA1[11])); mx = fmaxf(mx, fmaxf(fmaxf(pA1[12], pA1[13]), fmaxf(pA1[14], pA1[15]))); mx = swap32_max(mx);
        mrun = mx;
#pragma unroll
        for (int i = 0; i < 16; ++i) { negm[i] = -mx; pA0[i] = 0.f; pA1[i] = (i < 8) ? 0.f : __builtin_amdgcn_exp2f(pA1[i] - mx); }
    } else AT_ISSUE(0);
    AT_CLOSE(0);
    {
        int t = 1;
        for (; t + 1 < ntw; t += 2) {
            AT_STEP(pB0, pB1, pA0, pA1, t); AT_CLOSE(t);
            AT_STEP(pA0, pA1, pB0, pB1, t + 1); AT_CLOSE(t + 1);
        }
        if (ntw >= 1) {
            if (t < ntw) { AT_STEP(pB0, pB1, pA0, pA1, t); AT_CLOSE(t); ++t; AT_ISSUE(t); AT_SUMPACK(pB0, pB1); AT_PV(pB0, t - 1); }
            else { AT_ISSUE(t); AT_SUMPACK(pA0, pA1); AT_PV(pA0, t - 1); }
            AT_CLOSE(t); ++t;
        }
        for (; t <= nt; ++t) { AT_ISSUE(t); AT_CLOSE(t); }
    }
#undef AT_PIN
#undef AT_KF
#undef AT_VF
#undef AT_TR
#undef AT_YV
#undef AT_PB
#undef AT_ISSUE
#undef AT_CLOSE
#undef AT_ROWMAX
#undef AT_SUMPACK
#undef AT_PV
#undef AT_STEP
#undef AT_XV
#undef AT_EXP1
#undef AT_DMA_K
#undef AT_DMA_V
    const float l = swap32_sum(lrun);
    LAS float* X = (LAS float*)L;
    if (comp == 1) { const float sc = __uint_as_float(F.MISC[5]) * __builtin_amdgcn_rcpf(l);
#pragma unroll
        for (int d = 0; d < 4; ++d)
#pragma unroll
            for (int i = 0; i < 16; ++i) X[wq * 4096 + (32 * d + (i & 3) + 8 * (i >> 2) + 4 * hh) * 32 + m] = o[d][i] * sc; }
    __syncthreads();
    if (comp == 0) { const float inv = __builtin_amdgcn_rcpf(l); float ss = 0.f;
#pragma unroll
        for (int d = 0; d < 4; ++d)
#pragma unroll
            for (int i = 0; i < 16; ++i) { const float v = o[d][i] * inv - X[wq * 4096 + (32 * d + (i & 3) + 8 * (i >> 2) + 4 * hh) * 32 + m]; o[d][i] = v; ss += v * v; }
        ss = swap32_sum(ss);
        const float rstd = __builtin_amdgcn_rsqf(ss * (1.f / 128.f) + EPS) * 0.8f;
        if (valid) { bf16* orow = Ob + (size_t)r_of_bp(b, pq) * D + h * 128; const float* sg = F.in[I_ASUB];
#pragma unroll
            for (int d = 0; d < 4; ++d)
#pragma unroll
                for (int g = 0; g < 4; ++g) { const int dd = 32 * d + 8 * g + 4 * hh; const f32x4 gn = *(const f32x4*)(sg + dd);
                    *(v2u*)(orow + dd) = (v2u){pk2(o[d][4 * g] * rstd * gn[0], o[d][4 * g + 1] * rstd * gn[1]), pk2(o[d][4 * g + 2] * rstd * gn[2], o[d][4 * g + 3] * rstd * gn[3])}; } }
    }
    __syncthreads();
}

#ifndef DN_NSL
#define DN_NSL 2
#endif
constexpr int DN_WGS = 64 / DN_NSL;
constexpr int DS_W = 0, DS_Q = 17408, DS_KT = 34816, DS_QK = 53248, DS_STAGE = 62464, DS_GC = 124928;
constexpr int DS_ST = PRIV_OFF, DS_VN = PRIV_OFF + DN_NSL * 4352, DS_VS = DS_VN + DN_NSL * 2304;
constexpr int DS_UB = PRIV_OFF + 18432;
static_assert(DS_VS + DN_NSL * 2304 <= PRIV_OFF + 18432 && DS_UB + 2 * DN_NSL * 2048 <= LDS_BYTES, "scan LDS map");
constexpr int CW_DNDONE = 2048;
__device__ __forceinline__ void dn_scan(Frame& F, int unit) {
    LAS unsigned char* L = F.lds;
    const int bh = unit / (8 / DN_NSL), cg = unit % (8 / DN_NSL);
    int tz = F.wave * 64 + LANE_ID(); asm volatile("" : "+v"(tz));
    const int tid = tz, lane = tz & 63, wv = __builtin_amdgcn_readfirstlane(tz >> 6), col = lane & 15, q4 = lane >> 4;
    const bool roleA = wv < 4; const int rb = wv & 3;
    const unsigned char* blob0 = F.ws + WS_SCAN0 + (size_t)(bh * NCH) * DN_BLOB;
    f32x4 S[DN_NSL];
#pragma unroll
    for (int sl = 0; sl < DN_NSL; ++sl) S[sl] = (f32x4){0.f, 0.f, 0.f, 0.f};
    v4u pr[7]; float pgc = 0.f; v2u pu = (v2u){0u, 0u};
    const int id0 = tid, id1 = tid + 512;
#define DS_LOAD(n) do { const unsigned char* bl_ = blob0 + (size_t)(n) * DN_BLOB; \
        pr[0] = *(const v4u*)(bl_ + DN_W + id0 * 16); pr[1] = *(const v4u*)(bl_ + DN_W + id1 * 16); pr[2] = *(const v4u*)(bl_ + DN_Q + id0 * 16); pr[3] = *(const v4u*)(bl_ + DN_Q + id1 * 16); \
        pr[4] = *(const v4u*)(bl_ + DN_KT + id0 * 16); pr[5] = *(const v4u*)(bl_ + DN_KT + id1 * 16); pr[6] = *(const v4u*)(bl_ + DN_QK + id0 * 16); \
        if (tid < 64) pgc = *(const float*)(bl_ + DN_GC + tid * 4); \
        if (tid < 256 * DN_NSL) pu = *(const v2u*)(bl_ + DN_U + (size_t)((cg * DN_NSL * 256 + tid) * 4) * 2); } while (0)
#define DS_WRITE(s) do { LAS unsigned char* Ls_ = L + (s) * DS_STAGE; \
        *(LAS v4u*)(Ls_ + DS_W + (id0 >> 4) * 272 + (id0 & 15) * 16) = pr[0]; *(LAS v4u*)(Ls_ + DS_W + (id1 >> 4) * 272 + (id1 & 15) * 16) = pr[1]; \
        *(LAS v4u*)(Ls_ + DS_Q + (id0 >> 4) * 272 + (id0 & 15) * 16) = pr[2]; *(LAS v4u*)(Ls_ + DS_Q + (id1 >> 4) * 272 + (id1 & 15) * 16) = pr[3]; \
        *(LAS v4u*)(Ls_ + DS_KT + (id0 >> 3) * 144 + (id0 & 7) * 16) = pr[4]; *(LAS v4u*)(Ls_ + DS_KT + (id1 >> 3) * 144 + (id1 & 7) * 16) = pr[5]; \
        *(LAS v4u*)(Ls_ + DS_QK + (id0 >> 3) * 144 + (id0 & 7) * 16) = pr[6]; \
        if (tid < 64) *(LAS float*)(L + DS_GC + (s) * 256 + tid * 4) = pgc; \
        if (tid < 256 * DN_NSL) *(LAS v2u*)(L + DS_UB + (s) * (DN_NSL * 2048) + tid * 8) = pu; } while (0)
    DS_LOAD(0); DS_WRITE(0);
#pragma unroll
    for (int sl = 0; sl < DN_NSL; ++sl) *(LAS v2u*)(L + DS_ST + sl * 4352 + col * 272 + (16 * wv + 4 * q4) * 2) = (v2u){0u, 0u};
    __syncthreads();
    for (int n = 0; n < NCH; ++n) {
        const int cur = n & 1;
        const LAS unsigned char* Ls = L + cur * DS_STAGE; const LAS float* GC = (const LAS float*)(L + DS_GC + cur * 256);
        if (n + 1 < NCH) DS_LOAD(n + 1);
        const float gl = GC[63];
        const f32x4 gc4 = *(const LAS f32x4*)(GC + 16 * rb + 4 * q4);
        f32x4 ov[DN_NSL];
        {   bf16x8 fa[4];
            const LAS unsigned char* Ab = Ls + (roleA ? DS_W : DS_Q);
#pragma unroll
            for (int ks = 0; ks < 4; ++ks) fa[ks] = frag_nat(Ab, 272, 16 * rb + col, q4, ks);
#pragma unroll
            for (int sl = 0; sl < DN_NSL; ++sl) {
                bf16x8 fb[4];
#pragma unroll
                for (int ks = 0; ks < 4; ++ks) fb[ks] = frag_nat(L + DS_ST + sl * 4352, 272, col, q4, ks);
                f32x4 acc = (f32x4){0.f, 0.f, 0.f, 0.f};
#pragma unroll
                for (int ks = 0; ks < 4; ++ks) acc = MFMA16(fa[ks], fb[ks], acc);
                ov[sl] = (f32x4){0.f, 0.f, 0.f, 0.f};
                if (roleA) {
                    const v2u uw = *(const LAS v2u*)(L + DS_UB + cur * (DN_NSL * 2048) + (sl * 256 + rb * 64 + lane) * 8);
                    const f32x4 u = (f32x4){bflo(uw.x), bfhi(uw.x), bflo(uw.y), bfhi(uw.y)};
                    f32x4 vn, vs;
#pragma unroll
                    for (int r = 0; r < 4; ++r) { vn[r] = u[r] - acc[r]; vs[r] = vn[r] * fast_exp(gl - gc4[r]); }
                    *(LAS v2u*)(L + DS_VN + sl * 2304 + col * 144 + (16 * rb + 4 * q4) * 2) = (v2u){pk2(vn[0], vn[1]), pk2(vn[2], vn[3])};
                    *(LAS v2u*)(L + DS_VS + sl * 2304 + col * 144 + (16 * rb + 4 * q4) * 2) = (v2u){pk2(vs[0], vs[1]), pk2(vs[2], vs[3])};
                } else {
#pragma unroll
                    for (int r = 0; r < 4; ++r) ov[sl][r] = acc[r] * fast_exp(gc4[r]);
                }
            }
        }
        __syncthreads();
        {   bf16x8 fk[2], fq[2];
#pragma unroll
            for (int k2 = 0; k2 < 2; ++k2) { fk[k2] = frag_nat(Ls + DS_KT, 144, 16 * wv + col, q4, k2); fq[k2] = frag_nat(Ls + DS_QK, 144, 16 * rb + col, q4, k2); }
            const float egl = fast_exp(gl);
#pragma unroll
            for (int sl = 0; sl < DN_NSL; ++sl) {
                bf16x8 fv[2];
#pragma unroll
                for (int k2 = 0; k2 < 2; ++k2) fv[k2] = frag_nat(L + DS_VS + sl * 2304, 144, col, q4, k2);
                if (!roleA) { bf16x8 fn[2];
#pragma unroll
                    for (int k2 = 0; k2 < 2; ++k2) fn[k2] = frag_nat(L + DS_VN + sl * 2304, 144, col, q4, k2);
#pragma unroll
                    for (int k2 = 0; k2 < 2; ++k2) ov[sl] = MFMA16(fq[k2], fn[k2], ov[sl]);
                    *(v2u*)(F.ws + WS_VT + (size_t)(bh * NCH + n) * 16384 + (size_t)((((cg * DN_NSL + sl) * 4 + rb) * 64 + lane) * 4) * 2) = (v2u){pk2(ov[sl][0], ov[sl][1]), pk2(ov[sl][2], ov[sl][3])};
                }
                S[sl] = S[sl] * egl;
#pragma unroll
                for (int k2 = 0; k2 < 2; ++k2) S[sl] = MFMA16(fk[k2], fv[k2], S[sl]);
                *(LAS v2u*)(L + DS_ST + sl * 4352 + col * 272 + (16 * wv + 4 * q4) * 2) = (v2u){pk2(S[sl][0], S[sl][1]), pk2(S[sl][2], S[sl][3])};
            }
        }
        if (n + 1 < NCH) DS_WRITE(cur ^ 1);
        __syncthreads();
    }
#undef DS_LOAD
#undef DS_WRITE
    VM_WAIT();
    __syncthreads();
    if (tid == 0) { __builtin_amdgcn_fence(__ATOMIC_RELEASE, "agent"); VM_WAIT(); (void)__hip_atomic_fetch_add((unsigned*)(F.ctl + CW_DNDONE + 64 * bh), 1u, RLX_AGENT); }
}
__device__ __forceinline__ void dn_post_unit(Frame& F, int bh, int n, unsigned& seen, gu32* qh = nullptr) {
    const int b = bh >> 2, h = bh & 3;
    const bf16* BZ = (const bf16*)(F.ws + WS_BZ); bf16* Ob = (bf16*)(F.ws + WS_O);
    if (!((seen >> bh) & 1u)) { seen |= 1u << bh;
      if (F.wave * 64 + LANE_ID() == 0) { unsigned sp = 0;
        while (__hip_atomic_load((unsigned*)(F.ctl + CW_DNDONE + 64 * bh), RLX_AGENT) < (unsigned)(8 / DN_NSL)) { __builtin_amdgcn_s_sleep(4); if (++sp > (1u << 22)) { __hip_atomic_store((unsigned*)(F.ctl + CW_TMO), 1u, RLX_AGENT); break; } }
        __builtin_amdgcn_fence(__ATOMIC_ACQUIRE, "agent"); VM_WAIT(); }
      __syncthreads(); }
    const unsigned char* raw = F.ws + WS_VT + (size_t)(bh * NCH + n) * 16384;
    post_tile(F.wave, F.lds, raw, F.in[I_BOUTG],
              [&](int c) { const int pp = 64 * n + c; return BZ + (size_t)(b * LP + (pp < 48 ? 48 : pp)) * 512 + h * 128; },
              [&](int c) { const int pp = 64 * n + c; return Ob + (size_t)r_of_bp(b, pp < 48 ? 48 : pp) * D + 512 + h * 128; },
              [&](int c) { return 64 * n + c >= 48; }, nullptr, nullptr, nullptr, qh, F.MISC);
}

__device__ __forceinline__ void phase_attn(Frame& F, int qword, int mode) {
    const bool do_scan = mode != 1;
    int tz_ = F.wave * 64 + LANE_ID(); asm volatile("" : "+v"(tz_)); const int tid = tz_, lane = tz_ & 63, wave = __builtin_amdgcn_readfirstlane(tz_ >> 6); (void)tid; (void)lane; (void)wave;

    float lam;
    { int tz = F.wave * 64 + LANE_ID(); asm volatile("" : "+v"(tz)); const int ln = tz & 63;
      const float a = F.in[I_LQ1][ln] * F.in[I_LK1][ln], c = F.in[I_LQ2][ln] * F.in[I_LK2][ln]; lam = expf(wave_sum(a)) - expf(wave_sum(c)) + 0.2f; if (tid == 0) F.MISC[5] = __float_as_uint(lam); }
    if (do_scan && blockIdx.x < DN_WGS) dn_scan(F, (int)((blockIdx.x & 7) * (8 / DN_NSL) + (blockIdx.x >> 3)));
    constexpr int NATT = 129, NQ = NATT + NCH;
    unsigned seen_dn = 0u;
    for (int qi = 0; qi < 8; ++qi) {
        const int bh = (int)((blockIdx.x + qi) & 7);
        bool have = false;
        for (;;) {
            if (!have) { if (tid == 0) F.MISC[6] = __hip_atomic_fetch_add((unsigned*)(F.ctl + qword + 64 * bh), 1u, RLX_AGENT); __syncthreads(); }
            const int u = (int)F.MISC[6];
            __syncthreads();
            if (u >= NQ) break;
            if (u < NATT) { if (mode != 2) attn_unit(F, bh >> 2, bh & 3, 2 * (128 - u) - 1); have = false; }
            else if (mode != 1) { dn_post_unit(F, bh, u - NATT, seen_dn, F.ctl + qword + 64 * bh); have = true; }
            else have = false;
        }
    }
}

__device__ __forceinline__ void phase_norm(Frame& F, const float* gain, int nrows) {
    int tz_ = F.wave * 64 + LANE_ID(); asm volatile("" : "+v"(tz_)); const int tid = tz_, lane = tz_ & 63, wave = __builtin_amdgcn_readfirstlane(tz_ >> 6); (void)tid; (void)lane; (void)wave;

    const int gw = F.vcu * 8 + wave, NGW = F.G * 8;
    bf16* HN = (bf16*)(F.ws + WS_HN); const float* HM = (const float*)(F.ws + WS_HM);
    for (int r = gw; r < nrows; r += 2 * NGW) {
        const int r2 = r + NGW; const bool has2 = r2 < nrows; const int rb = has2 ? r2 : r;
        const float* srcA = (r < MR) ? F.out + (size_t)r * D : HM + (size_t)(r - MR) * D;
        const float* srcB = (rb < MR) ? F.out + (size_t)rb * D : HM + (size_t)(rb - MR) * D;
        f32x4 va[4], vb[4]; row_load(srcA, lane, va); row_load(srcB, lane, vb);
        float y[16]; rms_finish(va, gain, lane, y); store_row_bf16(HN + (size_t)r * D, lane, y);
        rms_finish(vb, gain, lane, y); if (has2) store_row_bf16(HN + (size_t)r2 * D, lane, y);
    }
}

constexpr int HQ_QA = 0, HQ_KB = 17408, HQ_GS = 34816;
constexpr int HQ_INQ = 40960, HQ_INF = 57344, HQ_OQG = 73728, HQ_OATT = 90112;
__device__ __forceinline__ void hg_prep_unit(Frame& F, int b, int h, int n) {
    LAS unsigned char* L = F.lds;
    int tz = F.wave * 64 + LANE_ID(); asm volatile("" : "+v"(tz));
    const int tid = tz, lane = tz & 63, wave = __builtin_amdgcn_readfirstlane(tz >> 6);
    const bf16* P1 = (const bf16*)(F.ws + WS_PROJ1);
    unsigned char* blob = F.ws + WS_SCAN1 + (size_t)((b * 8 + h) * NCH + n) * HG_BLOB;
    {
#pragma unroll
        for (int i = 0; i < 4; ++i) { const int idx = tid + 512 * i, which = idx >> 10, rem = idx & 1023, rrow = rem >> 4, ch = rem & 15; const int pp = 64 * n + rrow;
            const v4u x = *(const v4u*)(P1 + (size_t)r_of_bp(b, pp < 48 ? 48 : pp) * 4096 + which * 1024 + h * 128 + ch * 8);
            *(LAS v4u*)(L + (which ? HQ_INF : HQ_INQ) + rrow * 256 + ch * 16) = x; }
    }
    __syncthreads();
    {
        const int d = tid & 127, g = tid >> 7;
        const float l0 = F.in[I_LB][h * 128 + d], l1 = F.in[I_LB][D + h * 128 + d];
        const float lb = 1.f / (1.f + expf(l0 - l1));
        float c[16], qq[16], kk[16];
        float run = 0.f;
#pragma unroll
        for (int ii = 0; ii < 16; ++ii) { const int pp = 64 * n + 16 * g + ii;
            float q, k, lf;
            { const float q_ = bf2f(*(const LAS bf16*)(L + HQ_INQ + (16 * g + ii) * 256 + d * 2)); const float f = bf2f(*(const LAS bf16*)(L + HQ_INF + (16 * g + ii) * 256 + d * 2));
                const float fg = lb + (1.f - lb) * sigmoidf_(f); const bool ok = pp >= 48; lf = ok ? __builtin_amdgcn_logf(fg) * 0.6931471805599453f : 0.f; k = ok ? 1.f - fg : 0.f; q = ok ? q_ : 0.f; }
            run += lf; c[ii] = run; qq[ii] = q; kk[ii] = k; }
        LAS float* GS = (LAS float*)(L + HQ_GS);
        GS[g * 128 + d] = run;
        __syncthreads();
        const float s0 = GS[d], s1 = GS[128 + d], s2 = GS[256 + d], s3 = GS[384 + d];
        const float off = (g > 0 ? s0 : 0.f) + (g > 1 ? s1 : 0.f) + (g > 2 ? s2 : 0.f), tot = (s0 + s1) + (s2 + s3), gmid = s0 + s1;
        unsigned kd[8];
#pragma unroll
        for (int ii = 0; ii < 16; ++ii) { const int i = 16 * g + ii; const float gc = off + c[ii];
            const float qg = qq[ii] * fast_exp(gc), kdec = kk[ii] * fast_exp(tot - gc);
            const float qa = qq[ii] * fast_exp(fminf(gc - gmid, 80.f)), kb = kk[ii] * fast_exp(fminf(gmid - gc, 80.f));
            *(LAS bf16*)(L + HQ_OQG + (i * 128 + d) * 2) = f2bf(qg);
            *(LAS bf16*)(L + HQ_QA + i * 272 + d * 2) = f2bf(qa); *(LAS bf16*)(L + HQ_KB + i * 272 + d * 2) = f2bf(kb);
            if (ii & 1) kd[ii >> 1] |= ((unsigned)f2bf(kdec)) << 16; else kd[ii >> 1] = (unsigned)f2bf(kdec); }
        *(v4u*)(blob + HG_KDT + (d * 64 + 16 * g) * 2) = (v4u){kd[0], kd[1], kd[2], kd[3]}; *(v4u*)(blob + HG_KDT + (d * 64 + 16 * g) * 2 + 16) = (v4u){kd[4], kd[5], kd[6], kd[7]};
        if (g == 0) *(float*)(blob + HG_DEC + d * 4) = fast_exp(tot);
    }
    __syncthreads();
#pragma unroll
    for (int k = 0; k < 2; ++k) { const int idx = tid + 512 * k; *(v4u*)(blob + HG_QG + idx * 16) = *(const LAS v4u*)(L + HQ_OQG + idx * 16); }
    {
        const int row = lane & 15, quad = lane >> 4;
#pragma unroll
        for (int k = 0; k < 2; ++k) { const int idx = wave + 8 * k, ib = idx >> 2, jb = idx & 3;
            f32x4 acc = (f32x4){0.f, 0.f, 0.f, 0.f};
            if (jb <= ib) {
#pragma unroll
                for (int ks = 0; ks < 4; ++ks) acc = MFMA16(frag_nat(L + HQ_QA, 272, 16 * ib + row, quad, ks), frag_nat(L + HQ_KB, 272, 16 * jb + row, quad, ks), acc);
            }
            const int j = 16 * jb + row;
#pragma unroll
            for (int r = 0; r < 4; ++r) { const int i = 16 * ib + 4 * quad + r; *(LAS bf16*)(L + HQ_OATT + (i * 64 + j) * 2) = f2bf((j <= i) ? acc[r] : 0.f); } }
    }
    __syncthreads();
    *(v4u*)(blob + HG_ATT + tid * 16) = *(const LAS v4u*)(L + HQ_OATT + tid * 16);
}
__device__ __forceinline__ void phase_prep1(Frame& F) {
    for (int unit = F.vcu; unit < NB * 8 * NCH; unit += F.G) { const int bh = unit / NCH, n = unit % NCH; hg_prep_unit(F, bh >> 3, bh & 7, n); }
}

constexpr int HS_QG = 0, HS_ATT = 17408, HS_KDT = 26624, HS_DEC = 45056, HS_STAGE = 45568, HS_XS = 91136;
__device__ __forceinline__ void hg_scan(Frame& F, int unit) {
    const int bh = unit >> 4, sc = unit & 15, n0 = HG_SC * sc, n1 = (n0 + HG_SC < NCH) ? n0 + HG_SC : NCH;
    LAS unsigned char* L = F.lds;
    const int b = bh >> 3, h = bh & 7;
    int tz = F.wave * 64 + LANE_ID(); asm volatile("" : "+v"(tz));
    const int tid = tz, lane = tz & 63, wv = __builtin_amdgcn_readfirstlane(tz >> 6), col = lane & 15, q4 = lane >> 4, e0 = 16 * wv;
    const unsigned char* blob0 = F.ws + WS_SCAN1 + (size_t)(bh * NCH) * HG_BLOB;
    const bf16* P1 = (const bf16*)(F.ws + WS_PROJ1); bf16* O1 = (bf16*)(F.ws + WS_O1);
    f32x4 S[8], dprod[8];
#pragma unroll
    for (int t = 0; t < 8; ++t) { S[t] = (f32x4){0.f, 0.f, 0.f, 0.f}; dprod[t] = (f32x4){1.f, 1.f, 1.f, 1.f}; }
    v4u pr[5]; float pdec = 0.f;
    const int id0 = tid, id1 = tid + 512;
#define HS_LOAD(n) do { const unsigned char* bl_ = blob0 + (size_t)(n) * HG_BLOB; \
        pr[0] = *(const v4u*)(bl_ + HG_QG + id0 * 16); pr[1] = *(const v4u*)(bl_ + HG_QG + id1 * 16); pr[2] = *(const v4u*)(bl_ + HG_ATT + id0 * 16); \
        pr[3] = *(const v4u*)(bl_ + HG_KDT + id0 * 16); pr[4] = *(const v4u*)(bl_ + HG_KDT + id1 * 16); \
        if (tid < 128) pdec = *(const float*)(bl_ + HG_DEC + tid * 4); } while (0)
#define HS_WRITE(s) do { LAS unsigned char* Ls_ = L + (s) * HS_STAGE; \
        *(LAS v4u*)(Ls_ + HS_QG + (id0 >> 4) * 272 + (id0 & 15) * 16) = pr[0]; *(LAS v4u*)(Ls_ + HS_QG + (id1 >> 4) * 272 + (id1 & 15) * 16) = pr[1]; \
        *(LAS v4u*)(Ls_ + HS_ATT + (id0 >> 3) * 144 + (id0 & 7) * 16) = pr[2]; \
        *(LAS v4u*)(Ls_ + HS_KDT + (id0 >> 3) * 144 + (id0 & 7) * 16) = pr[3]; *(LAS v4u*)(Ls_ + HS_KDT + (id1 >> 3) * 144 + (id1 & 7) * 16) = pr[4]; \
        if (tid < 128) *(LAS float*)(Ls_ + HS_DEC + tid * 4) = pdec; } while (0)
    v4u inx[2];
    LAS unsigned char* ITW = L + PRIV_OFF + wv * 2304;
#define HS_LOADI(n, I) do { const int pp_ = 64 * (n) + lane; const bf16* src_ = P1 + (size_t)r_of_bp(b, pp_ < 48 ? 48 : pp_) * 4096 + 2048 + h * 128 + e0; \
        I[0] = *(const v4u*)src_; I[1] = *(const v4u*)(src_ + 8); if (pp_ < 48) { I[0] = (v4u){0u, 0u, 0u, 0u}; I[1] = (v4u){0u, 0u, 0u, 0u}; } } while (0)
#define HS_WRITEI(I) do { \
        _Pragma("unroll") for (int hf_ = 0; hf_ < 2; ++hf_) { const unsigned w0_ = I[hf_].x, w1_ = I[hf_].y, w2_ = I[hf_].z, w3_ = I[hf_].w; LAS unsigned char* d_ = ITW + (8 * hf_) * 144 + lane * 2; \
            *(LAS bf16*)(d_) = (bf16)(w0_ & 0xffffu); *(LAS bf16*)(d_ + 144) = (bf16)(w0_ >> 16); *(LAS bf16*)(d_ + 288) = (bf16)(w1_ & 0xffffu); *(LAS bf16*)(d_ + 432) = (bf16)(w1_ >> 16); \
            *(LAS bf16*)(d_ + 576) = (bf16)(w2_ & 0xffffu); *(LAS bf16*)(d_ + 720) = (bf16)(w2_ >> 16); *(LAS bf16*)(d_ + 864) = (bf16)(w3_ & 0xffffu); *(LAS bf16*)(d_ + 1008) = (bf16)(w3_ >> 16); } } while (0)
#define HS_LOADZ(n, Z) do { \
        _Pragma("unroll") for (int rb = 0; rb < 4; ++rb) _Pragma("unroll") for (int r = 0; r < 4; ++r) { const int pp_ = 64 * (n) + 16 * rb + 4 * q4 + r; \
            Z[4 * rb + r] = P1[(size_t)(b * SEQ + (pp_ < 64 ? 64 : pp_) - 64) * 4096 + 3072 + h * 128 + e0 + col]; } } while (0)
    HS_LOAD(n0); HS_WRITE(0); HS_LOADI(n0, inx); HS_WRITEI(inx);
    __syncthreads();
    for (int n = n0; n < n1; ++n) {
        const int cur = (n - n0) & 1;
        const LAS unsigned char* Ls = L + cur * HS_STAGE; const LAS float* DEC = (const LAS float*)(Ls + HS_DEC);
        if (n + 1 < n1) { HS_LOAD(n + 1); HS_LOADI(n + 1, inx); }
        bf16x8 Sb[4], ib[2];
#pragma unroll
        for (int ks = 0; ks < 4; ++ks) Sb[ks] = pack_tiles(S[2 * ks], S[2 * ks + 1]);
#pragma unroll
        for (int k2 = 0; k2 < 2; ++k2) ib[k2] = frag_pi(ITW, 144, col, q4, k2);
        f32x4 ov[4];
#pragma unroll
        for (int rh = 0; rh < 2; ++rh) {
            bf16x8 fa[8], fb[4];
#pragma unroll
            for (int r2 = 0; r2 < 2; ++r2) { const int rb = 2 * rh + r2;
#pragma unroll
                for (int ks = 0; ks < 4; ++ks) fa[r2 * 4 + ks] = frag_pi(Ls + HS_QG, 272, 16 * rb + col, q4, ks);
#pragma unroll
                for (int k2 = 0; k2 < 2; ++k2) fb[r2 * 2 + k2] = frag_pi(Ls + HS_ATT, 144, 16 * rb + col, q4, k2); }
            SCHED_BAR();
#pragma unroll
            for (int r2 = 0; r2 < 2; ++r2) { const int rb = 2 * rh + r2; ov[rb] = (f32x4){0.f, 0.f, 0.f, 0.f};
#pragma unroll
                for (int ks = 0; ks < 4; ++ks) ov[rb] = MFMA16(fa[r2 * 4 + ks], Sb[ks], ov[rb]);
#pragma unroll
                for (int k2 = 0; k2 < 2; ++k2) ov[rb] = MFMA16(fb[r2 * 2 + k2], ib[k2], ov[rb]); }
            SCHED_BAR();
        }
#pragma unroll
        for (int th = 0; th < 2; ++th) {
            bf16x8 fa[8]; f32x4 dc[4];
#pragma unroll
            for (int t = 0; t < 4; ++t) { dc[t] = *(const LAS f32x4*)(DEC + 16 * (4 * th + t) + 4 * q4);
#pragma unroll
                for (int k2 = 0; k2 < 2; ++k2) fa[t * 2 + k2] = frag_pi(Ls + HS_KDT, 144, 16 * (4 * th + t) + col, q4, k2); }
            SCHED_BAR();
#pragma unroll
            for (int t = 0; t < 4; ++t) { S[4 * th + t] = S[4 * th + t] * dc[t];
                if (wv == 0 && col == 0) *(f32x4*)((unsigned char*)blob0 + (size_t)n * HG_BLOB + HG_DEC + (16 * (4 * th + t) + 4 * q4) * 4) = dprod[4 * th + t];
                dprod[4 * th + t] = dprod[4 * th + t] * dc[t];
#pragma unroll
                for (int k2 = 0; k2 < 2; ++k2) S[4 * th + t] = MFMA16(fa[t * 2 + k2], ib[k2], S[4 * th + t]); }
            SCHED_BAR();
        }
        { unsigned char* blw = (unsigned char*)blob0 + (size_t)n * HG_BLOB;
#pragma unroll
          for (int rb = 0; rb < 4; ++rb) *(v2u*)(blw + HG_KDT + (size_t)(((wv * 4 + rb) * 64 + lane) * 4) * 2) = (v2u){pk2(ov[rb][0], ov[rb][1]), pk2(ov[rb][2], ov[rb][3])}; }
        if (n + 1 < n1) { HS_WRITE(cur ^ 1); HS_WRITEI(inx); }
        __syncthreads();
    }
#undef HS_LOAD
#undef HS_WRITE
#undef HS_LOADI
#undef HS_WRITEI
#undef HS_LOADZ
    { float* sl = (float*)(F.ws + WS_SLOC) + (size_t)unit * 16384;
#pragma unroll
      for (int t = 0; t < 8; ++t) *(f32x4*)(sl + ((wv * 8 + t) * 64 + lane) * 4) = S[t];
      if (wv == 0 && col == 0) { float* dd = (float*)(F.ws + WS_DECSC) + (size_t)unit * 128;
#pragma unroll
          for (int t = 0; t < 8; ++t) *(f32x4*)(dd + 16 * t + 4 * q4) = dprod[t]; } }
    __syncthreads();
}
__device__ __forceinline__ void phase_hg_carry(Frame& F) {
    int tz_ = F.wave * 64 + LANE_ID(); asm volatile("" : "+v"(tz_));
    const float* SL = (const float*)(F.ws + WS_SLOC); const float* DS = (const float*)(F.ws + WS_DECSC); bf16* ST = (bf16*)(F.ws + WS_SINT);
    for (int g = (int)blockIdx.x * 512 + tz_; g < 16 * 4096; g += F.G * 512) {
        const int bh = g >> 12, gid = g & 4095, wv = gid >> 9, t = (gid >> 6) & 7, ln = gid & 63, q4 = ln >> 4, col = ln & 15, d0 = 16 * t + 4 * q4, e = 16 * wv + col;
        f32x4 s = (f32x4){0.f, 0.f, 0.f, 0.f};
        for (int sc = 0; sc + 1 < HG_NSC; ++sc) {
            const f32x4 dc = *(const f32x4*)(DS + (size_t)(bh * 16 + sc) * 128 + d0), lo = *(const f32x4*)(SL + (size_t)(bh * 16 + sc) * 16384 + (size_t)gid * 4);
            s = s * dc + lo;
            *(v2u*)(ST + ((size_t)(bh * 16 + sc + 1) * 128 + e) * 128 + d0) = (v2u){pk2(s[0], s[1]), pk2(s[2], s[3])};
        }
    }
}

__device__ __forceinline__ void phase_hg_post(Frame& F) {
    const bf16* P1 = (const bf16*)(F.ws + WS_PROJ1); bf16* O1 = (bf16*)(F.ws + WS_O1);
    constexpr int NT = 16 * (NCH - 1);
    for (int run = F.vcu; run * 16 < NT; run += F.G) { const int bh = (run * 16) / (NCH - 1), b = bh >> 3, h = bh & 7, na = 1 + (run * 16) % (NCH - 1);
        int staged = -1;
        for (int n = na; n < na + 16 && n < NCH; ++n) { const int sc = n / HG_SC;
            const bf16* sin = (const bf16*)(F.ws + WS_SINT) + (size_t)(bh * 16 + sc) * 16384;
            const unsigned char* blob = F.ws + WS_SCAN1 + (size_t)(bh * NCH + n) * HG_BLOB;
            post_tile(F.wave, F.lds, blob + HG_KDT, F.in[I_COUTG],
                      [&](int c) { return P1 + (size_t)(b * SEQ + 64 * n + c - 64) * 4096 + 3072 + h * 128; },
                      [&](int c) { return O1 + (size_t)(b * SEQ + 64 * n + c - 64) * D + h * 128; },
                      [&](int c) { return true; },
                      sc > 0 ? (const bf16*)(blob + HG_QG) : (const bf16*)nullptr, (const float*)(blob + HG_DEC), (sc > 0 && staged != sc) ? sin : (const bf16*)nullptr);
            staged = sc;
        }
    }
}

__device__ __forceinline__ void phase_route(Frame& F) {
    int tz_ = F.wave * 64 + LANE_ID(); asm volatile("" : "+v"(tz_)); const int tid = tz_, lane = tz_ & 63, wave = __builtin_amdgcn_readfirstlane(tz_ >> 6); (void)tid; (void)lane; (void)wave;

    LAS float* scr = (LAS float*)(F.lds + wave * 8448);
    const int gw = F.vcu * 8 + wave, NGW = F.G * 8;
    unsigned char* WM13 = F.ws + WS_WM13; unsigned char* WM2 = F.ws + WS_WM2;
    constexpr int I_UP = 16 * 112, I_DN = 56 * 32, PER_E = 2 * I_UP + I_DN, NITEMS = NEXP * PER_E;
    int it = gw; const int nitw = (NITEMS - gw + NGW - 1) / NGW; int done = 0;
#define RT_ITEMS(upto) do { while (done < (upto) && it < NITEMS) { const int e = it / PER_E; int r = it % PER_E; \
        if (r < I_UP) transpose_item_fp8<1>(F.in[I_MW1] + (size_t)e * D * DFFE, DFFE, D, DFFE, WM13 + (size_t)e * 7168 * D, 0, scr, r, lane, SC_W13); \
        else if (r < 2 * I_UP) transpose_item_fp8<1>(F.in[I_MW3] + (size_t)e * D * DFFE, DFFE, D, DFFE, WM13 + (size_t)e * 7168 * D, 128, scr, r - I_UP, lane, SC_W13); \
        else transpose_item_fp8<0>(F.in[I_MW2] + (size_t)e * DFFE * D, D, DFFE, D, WM2 + (size_t)e * D * DFFE, 0, scr, r - 2 * I_UP, lane, SC_W2); \
        it += NGW; ++done; } } while (0)
    LAS float* RT = (LAS float*)(F.lds + 69632);
    LAS int* cnt = (LAS int*)(F.lds + 102400);
    for (int k = tid; k < D; k += 512) { const f32x4* p = (const f32x4*)(F.in[I_ROUTER] + (size_t)k * 8); const f32x4 a = p[0], c = p[1];
        RT[0 * D + k] = a[0]; RT[1 * D + k] = a[1]; RT[2 * D + k] = a[2]; RT[3 * D + k] = a[3]; RT[4 * D + k] = c[0]; RT[5 * D + k] = c[1]; RT[6 * D + k] = c[2]; RT[7 * D + k] = c[3]; }
    unsigned char* HN8 = F.ws + WS_HN;
    int* tokinfo = (int*)(F.ws + WS_ROUTE + RT_TOKINFO); int* wgcnt = (int*)(F.ws + WS_ROUTE + RT_WGCNT);
    const float* gain = F.in[I_FFNN] + D;
    bool firstblk = true;
    for (int blk = (int)blockIdx.x; blk < 256; blk += F.G) {
        if (tid < 8) cnt[tid] = 0;
        __syncthreads();
        f32x4 vrow[4]; row_load(F.out + (size_t)(blk * 128 + wave * 16) * D, lane, vrow);
        for (int rr = 0; rr < 16; ++rr) {
            const int t = blk * 128 + wave * 16 + rr;
            float y[16]; rms_finish_exact(vrow, gain, lane, y);
            row_load(F.out + (size_t)(rr < 15 ? t + 1 : t) * D, lane, vrow);
            { unsigned* o4 = (unsigned*)(HN8 + (size_t)t * D) + lane;
#pragma unroll
              for (int j = 0; j < 4; ++j) o4[64 * j] = pk4_fp8(y[4 * j] * SC_X, y[4 * j + 1] * SC_X, y[4 * j + 2] * SC_X, y[4 * j + 3] * SC_X); }
            float lg[8];
#pragma unroll
            for (int j = 0; j < 8; ++j) { float s = 0.f;
#pragma unroll
                for (int jj = 0; jj < 4; ++jj) { const f32x4 w = *(const LAS f32x4*)(RT + j * D + 4 * lane + 256 * jj); s += y[4 * jj] * w[0] + y[4 * jj + 1] * w[1] + y[4 * jj + 2] * w[2] + y[4 * jj + 3] * w[3]; }
                lg[j] = wave_sum(s); }
            int e0 = 0; float v0 = lg[0];
#pragma unroll
            for (int j = 1; j < 8; ++j) if (lg[j] > v0) { v0 = lg[j]; e0 = j; }
            int e1 = -1; float v1 = -INFINITY;
#pragma unroll
            for (int j = 0; j < 8; ++j) if (j != e0 && lg[j] > v1) { v1 = lg[j]; e1 = j; }
            const float g0 = 1.f / (1.f + expf(v1 - v0));
            if (lane == 0) {
                const int r0 = __hip_atomic_fetch_add(cnt + e0, 1, __ATOMIC_RELAXED, __HIP_MEMORY_SCOPE_WORKGROUP), r1 = __hip_atomic_fetch_add(cnt + e1, 1, __ATOMIC_RELAXED, __HIP_MEMORY_SCOPE_WORKGROUP);
                *(int4*)(tokinfo + (size_t)t * 4) = make_int4(e0 | (e1 << 8), __float_as_int(g0), r0, r1); }
            if (firstblk) RT_ITEMS(((rr + 1) * nitw) >> 4);
        }
        firstblk = false;
        __syncthreads();
        if (tid < 8) wgcnt[blk * 8 + tid] = cnt[tid];
        __syncthreads();
    }
    RT_ITEMS(nitw);
#undef RT_ITEMS
}
__device__ __forceinline__ void phase_gather(Frame& F) {
    int tz_ = F.wave * 64 + LANE_ID(); asm volatile("" : "+v"(tz_)); const int tid = tz_, lane = tz_ & 63, wave = __builtin_amdgcn_readfirstlane(tz_ >> 6); (void)tid; (void)lane; (void)wave;

    LAS int* T = (LAS int*)F.lds;
    LAS int* PERS = (LAS int*)(F.lds + PERS_OFF);
    const int* wgcnt = (const int*)(F.ws + WS_ROUTE + RT_WGCNT);
    int* tokinfo = (int*)(F.ws + WS_ROUTE + RT_TOKINFO); int* rowtok = (int*)(F.ws + WS_ROUTE + RT_ROWTOK); float* rowgate = (float*)(F.ws + WS_ROUTE + RT_ROWGATE);
    const unsigned char* HN8 = F.ws + WS_HN; unsigned char* XG = F.ws + WS_XG;
    { const int e = wave;
      int c4[4], ssum = 0;
#pragma unroll
      for (int i = 0; i < 4; ++i) { c4[i] = wgcnt[(4 * lane + i) * 8 + e]; ssum += c4[i]; }
      int incl = ssum;
#pragma unroll
      for (int o = 1; o < 64; o <<= 1) { const int t = __shfl_up(incl, o); if (lane >= o) incl += t; }
      int run = incl - ssum;
#pragma unroll
      for (int i = 0; i < 4; ++i) { T[32 + (4 * lane + i) * 8 + e] = run; run += c4[i]; }
      if (lane == 63) T[e] = incl; }
    __syncthreads();
    if (tid == 0) { int ps = 0; for (int e = 0; e < 8; ++e) { T[8 + e] = ps; ps += (T[e] + 255) / 256 * 256; T[16 + e] = ps; PERS[e] = ps; } PERS[8] = ps / 256; }
    __syncthreads();
    { const int ntl = PERS[8]; LAS unsigned char* te = (LAS unsigned char*)(PERS + 16);
      for (int t = tid; t < ntl; t += 512) { int e = 0; while (e < 7 && PERS[e] <= 256 * t) ++e; te[t] = (unsigned char)e; } }
    for (int blk = (int)blockIdx.x; blk < 256; blk += F.G) {
        for (int pi = wave; pi < 256; pi += 8) {
            const int t = blk * 128 + (pi >> 1), s = pi & 1;
            const int4 ti = *(const int4*)(tokinfo + (size_t)t * 4);
            const int e = s ? ((ti.x >> 8) & 0xff) : (ti.x & 0xff); const float g0 = __int_as_float(ti.y); const float g = s ? 1.f - g0 : g0; const int rank = s ? ti.w : ti.z;
            const int dest = T[8 + e] + T[32 + blk * 8 + e] + rank;
            *((v4u*)(XG + (size_t)dest * D) + lane) = *((const v4u*)(HN8 + (size_t)t * D) + lane);
            if (lane == 0) { rowtok[dest] = t; rowgate[dest] = g; tokinfo[(size_t)t * 4 + 2 + s] = dest; }
        }
    }
    if (blockIdx.x < 8) { const int e = (int)blockIdx.x; const int lo = T[8 + e] + T[e], hi = T[16 + e];
        for (int r = lo + wave; r < hi; r += 8) { v2u* dst = (v2u*)(XG + (size_t)r * D) + lane; dst[0] = (v2u){0u, 0u}; dst[64] = (v2u){0u, 0u}; if (lane == 0) { rowtok[r] = -1; rowgate[r] = 0.f; } } }
}
struct MoeOrder {
    pg8::StaticOrder so; int tile0, slot0; bool up; const LAS unsigned char* te;
    int nd, take;
    __device__ bool next(int i, Unit& u) const {
        long L;
        if (nd == 0) L = (long)i * so.G + so.c;
        else if (so.c < nd) { if (i >= take) return false; L = (long)so.c * take + i; }
        else L = (long)nd * take + (so.c - nd) + (long)i * (so.G - nd);
        if (!so.map(L, u)) return false;
        const int tile = tile0 + u.pm; const int e = te[tile];
        if (up) { u.arow = tile * 256; u.brow = e * 7168 + u.pn * 256; u.orow = (slot0 + u.pm) * 256; }
        else { u.arow = (slot0 + u.pm) * 256; u.brow = e * 1024 + u.pn * 256; u.orow = tile * 256; }
        u.pm = tile; u.nrow = 256; return true;
    }
};
__device__ __forceinline__ void phase_combine(Frame& F) {
    int tz_ = F.wave * 64 + LANE_ID(); asm volatile("" : "+v"(tz_)); const int tid = tz_, lane = tz_ & 63, wave = __builtin_amdgcn_readfirstlane(tz_ >> 6); (void)tid; (void)lane; (void)wave;

    const int gw = F.vcu * 8 + wave, NGW = F.G * 8;
    const int* tokinfo = (const int*)(F.ws + WS_ROUTE + RT_TOKINFO); const bf16* Y = (const bf16*)(F.ws + WS_Y);
    static_assert(MR % 2 == 0, "token pairs");
    for (int t = 2 * gw; t < MR; t += 2 * NGW) {
        const int4 tA = *(const int4*)(tokinfo + (size_t)t * 4), tB = *(const int4*)(tokinfo + (size_t)(t + 1) * 4);
        f32x4* oA = (f32x4*)(F.out + (size_t)t * D) + lane; f32x4* oB = oA + D / 4;
        const v2u* a0 = (const v2u*)(Y + (size_t)tA.z * D) + lane; const v2u* a1 = (const v2u*)(Y + (size_t)tA.w * D) + lane;
        const v2u* b0 = (const v2u*)(Y + (size_t)tB.z * D) + lane; const v2u* b1 = (const v2u*)(Y + (size_t)tB.w * D) + lane;
        f32x4 vA[4], vB[4]; v2u pa[4], pc[4], qa[4], qc[4];
#pragma unroll
        for (int j = 0; j < 4; ++j) { vA[j] = oA[64 * j]; pa[j] = a0[64 * j]; pc[j] = a1[64 * j]; vB[j] = oB[64 * j]; qa[j] = b0[64 * j]; qc[j] = b1[64 * j]; }
#pragma unroll
        for (int j = 0; j < 4; ++j) { f32x4 v = vA[j]; v[0] += bflo(pa[j].x) + bflo(pc[j].x); v[1] += bfhi(pa[j].x) + bfhi(pc[j].x); v[2] += bflo(pa[j].y) + bflo(pc[j].y); v[3] += bfhi(pa[j].y) + bfhi(pc[j].y); oA[64 * j] = v; }
#pragma unroll
        for (int j = 0; j < 4; ++j) { f32x4 v = vB[j]; v[0] += bflo(qa[j].x) + bflo(qc[j].x); v[1] += bfhi(qa[j].x) + bfhi(qc[j].x); v[2] += bflo(qa[j].y) + bflo(qc[j].y); v[3] += bfhi(qa[j].y) + bfhi(qc[j].y); oB[64 * j] = v; }
    }
}


template <bool PAIR, int K, class EE>
__device__ __forceinline__ void meta_gemm(Frame& F, const bf16* A, const bf16* Bt, int nblk, const EE& epi) {
    int tz_ = F.wave * 64 + LANE_ID(); asm volatile("" : "+v"(tz_)); const int tid = tz_, lane = tz_ & 63, wave = __builtin_amdgcn_readfirstlane(tz_ >> 6);
    LAS float* red = (LAS float*)F.lds;
    const int row = lane & 15, quad = lane >> 4; constexpr int kw = K / 8;
    for (int b = F.vcu; b < nblk; b += F.G) {
        const int brow0 = PAIR ? ((16 * b) >> 7) * 256 + ((16 * b) & 127) : 16 * b;
        f32x4 a00 = (f32x4){0.f, 0.f, 0.f, 0.f}, a01 = a00, a10 = a00, a11 = a00;
        const bf16* ap = A + (size_t)row * K + wave * kw + 8 * quad; const bf16* bp = Bt + (size_t)(brow0 + row) * K + wave * kw + 8 * quad;
#pragma unroll 4
        for (int k = 0; k < kw; k += 32) {
            const bf16x8 x0 = *(const bf16x8*)(ap + k), x1 = *(const bf16x8*)(ap + (size_t)16 * K + k), w0 = *(const bf16x8*)(bp + k);
            a00 = MFMA16(x0, w0, a00); a01 = MFMA16(x1, w0, a01);
            if (PAIR) { const bf16x8 w1 = *(const bf16x8*)(bp + (size_t)128 * K + k); a10 = MFMA16(x0, w1, a10); a11 = MFMA16(x1, w1, a11); }
        }
#pragma unroll
        for (int r = 0; r < 4; ++r) { red[(wave * 32 + 4 * quad + r) * 16 + row] = a00[r]; red[(wave * 32 + 16 + 4 * quad + r) * 16 + row] = a01[r];
            if (PAIR) { red[4096 + (wave * 32 + 4 * quad + r) * 16 + row] = a10[r]; red[4096 + (wave * 32 + 16 + 4 * quad + r) * 16 + row] = a11[r]; } }
        __syncthreads();
        { const int rr = tid >> 4, cc = tid & 15; float v = 0.f, v2 = 0.f;
#pragma unroll
          for (int w = 0; w < 8; ++w) { v += red[(w * 32 + rr) * 16 + cc]; if (PAIR) v2 += red[4096 + (w * 32 + rr) * 16 + cc]; }
          epi(rr, 16 * b + cc, v, v2); }
        __syncthreads();
    }
}
constexpr int N_PHASES = 23;
#ifndef MK_PER_PHASE
#define MK_PER_PHASE 0
#endif
struct Args { const float* in[28]; float* out; unsigned char* ws; int ph_lo, ph_hi, dup, pad; };
__global__ void __launch_bounds__(512, 2) mk_fwd(Args args) {
    extern __shared__ __attribute__((aligned(16))) unsigned char lds[];
    Frame F;
    F.lds = (LAS unsigned char*)lds;
    F.MISC = (volatile LAS unsigned*)(F.lds + MISC_OFF);
    F.wave = __builtin_amdgcn_readfirstlane((int)threadIdx.x >> 6); F.tid = F.wave * 64 + LANE_ID(); F.lane = F.tid & 63;
    F.G = gridDim.x; { const int bx = blockIdx.x; F.vcu = (F.G % 8 == 0) ? (bx % 8) * (F.G / 8) + bx / 8 : bx; }
    F.ws = args.ws; F.ctl = (gu32*)(args.ws + WS_CTL); F.out = args.out;
    F.in.base = (const __attribute__((address_space(4))) unsigned long long*)__builtin_amdgcn_kernarg_segment_ptr();
    for (int u = F.tid; u < (LDS_BYTES - LDSCTL_OFF) / 4; u += 512) ((LAS unsigned*)(F.lds + LDSCTL_OFF))[u] = 0u;
    __syncthreads();
    XcdBarrier bar = xcd_barrier_post((unsigned*)(F.ctl + CW_BAR), F.MISC + 8, F.wave);
    const int lo = args.ph_lo, hi = args.ph_hi;
#define IN(k) (lo <= (k) && (k) < hi)
#define SEAM(k) do { if (IN(k) && IN((k) + 1)) xcd_barrier(bar); } while (0)
#ifndef DUP_MASK
#define DUP_MASK 0u
#endif
#ifndef ATT_PROBE_MODE
#define ATT_PROBE_MODE 0
#endif
#define NREP(k) ((int)((DUP_MASK >> (k)) & 1u) * args.dup + 1)
    unsigned char* ws = args.ws;
    bf16* HN = (bf16*)(ws + WS_HN); float* HM = (float*)(ws + WS_HM);

    if (IN(0)) { for (int rep = 0; rep < NREP(0); ++rep) { if (rep) xcd_barrier(bar); phase_prologue(F); } } SEAM(0);
    if (IN(1)) for (int rep = 0; rep < NREP(1); ++rep) {
        if (rep) xcd_barrier(bar);
        pg8::Gemm g{HN, (const bf16*)(ws + WS_WIN0), D}; pg8::StaticOrder S; S.init(MR / 256, NPROJ0 / 256, F.G, (int)blockIdx.x);
        EpiProj0 E{(bf16*)(ws + WS_Q), (bf16*)(ws + WS_K), (bf16*)(ws + WS_VR), (bf16*)(ws + WS_CRAW), (bf16*)(ws + WS_BZ)};
        { bf16* Qm = (bf16*)(ws + WS_Q); bf16* Km = (bf16*)(ws + WS_K); bf16* Vm = (bf16*)(ws + WS_VR); bf16* Cm = (bf16*)(ws + WS_CRAW); bf16* Zm = (bf16*)(ws + WS_BZ);
          meta_gemm<false, D>(F, HN + (size_t)MR * D, g.Bt, NPROJ0 / 16, [&](int r, int c, float v, float) { const size_t pr = (size_t)prow_of_r(MR + r);
              if (c < 512) Qm[pr * 512 + c] = f2bf(v); else if (c < 1024) Km[pr * 512 + c - 512] = f2bf(v); else if (c < 1536) Vm[pr * 512 + c - 1024] = f2bf(v);
              else if (c < 3072) Cm[pr * 1536 + c - 1536] = f2bf(v); else Zm[pr * 512 + c - 3072] = f2bf(v); }); }
        pg8::gemm_phase(F.wave, F.lds, g, S, E); } SEAM(1);
    if (IN(2)) { phase_prep0(F, true); for (int rep = 1; rep < NREP(2); ++rep) { xcd_barrier(bar); phase_prep0(F, false); } } SEAM(2);
#ifndef SPLIT_P3
#define SPLIT_P3 0
#endif
    if (IN(3)) { if (SPLIT_P3) { phase_attn(F, CW_QHEAD, 2); xcd_barrier(bar); phase_attn(F, CW_QHEAD + 512, 1); }
        else for (int rep = 0; rep < NREP(3); ++rep) { if (rep) xcd_barrier(bar); phase_attn(F, CW_QHEAD + 512 * rep, rep == 0 ? 0 : ATT_PROBE_MODE); } } SEAM(3);
    if (IN(4)) {
        pg8::Gemm g{(const bf16*)(ws + WS_O), (const bf16*)(ws + WS_WOUT0), D}; pg8::StaticOrder S; S.init(MR / 256, 4, F.G, (int)blockIdx.x);
        EpiResid E{F.in[I_X], F.in[I_META], 15, F.out, HM};
        { const float* mt = F.in[I_META]; meta_gemm<false, D>(F, g.A + (size_t)MR * D, g.Bt, D / 16, [&](int r, int c, float v, float) { HM[(size_t)r * D + c] = mt[(size_t)(r & 15) * D + c] + v; }); }
        pg8::gemm_phase(F.wave, F.lds, g, S, E); } SEAM(4);
    if (IN(5)) { for (int rep = 0; rep < NREP(5); ++rep) { if (rep) xcd_barrier(bar); phase_norm(F, F.in[I_FFNN], MROWS); } } SEAM(5);
    if (IN(6)) for (int rep = 0; rep < NREP(6); ++rep) {
        if (rep) xcd_barrier(bar);
        pg8::Gemm g{HN, (const bf16*)(ws + WS_W13), D}; pg8::StaticOrder S; S.init(MR / 256, 2 * DFF / 256, F.G, (int)blockIdx.x);
        EpiSwiglu E{(bf16*)(ws + WS_H0), DFF};
        { bf16* Hm = (bf16*)(ws + WS_H0) + (size_t)MR * DFF; meta_gemm<true, D>(F, HN + (size_t)MR * D, g.Bt, DFF / 16, [&](int r, int c, float a, float b2) { Hm[(size_t)r * DFF + c] = f2bf(siluf_(a) * b2); }); }
        pg8::gemm_phase(F.wave, F.lds, g, S, E); } SEAM(6);
    if (IN(7)) {
        pg8::Gemm g{(const bf16*)(ws + WS_H0), (const bf16*)(ws + WS_W2), DFF}; pg8::StaticOrder S; S.init(MR / 256, 4, F.G, (int)blockIdx.x);
        EpiResid E{F.out, HM, 31, F.out, HM};
        meta_gemm<false, DFF>(F, g.A + (size_t)MR * DFF, g.Bt, D / 16, [&](int r, int c, float v, float) { HM[(size_t)r * D + c] += v; });
        pg8::gemm_phase(F.wave, F.lds, g, S, E); } SEAM(7);
    if (IN(8)) { for (int rep = 0; rep < NREP(8); ++rep) { if (rep) xcd_barrier(bar); phase_norm(F, F.in[I_MIXN] + D, MROWS); } } SEAM(8);
    if (IN(9)) for (int rep = 0; rep < NREP(9); ++rep) {
        if (rep) xcd_barrier(bar);
        pg8::Gemm g{HN, (const bf16*)(ws + WS_WIN1), D}; pg8::StaticOrder S; S.init(MR / 256, 16, F.G, (int)blockIdx.x);
        EpiBf16 E{(bf16*)(ws + WS_PROJ1), 4096};
        { bf16* Pm = (bf16*)(ws + WS_PROJ1) + (size_t)MR * 4096; meta_gemm<false, D>(F, HN + (size_t)MR * D, g.Bt, 4096 / 16, [&](int r, int c, float v, float) { Pm[(size_t)r * 4096 + c] = f2bf(v); }); }
        pg8::gemm_phase(F.wave, F.lds, g, S, E); } SEAM(9);
    if (IN(10)) { for (int rep = 0; rep < NREP(10); ++rep) { if (rep) xcd_barrier(bar); phase_prep1(F); } } SEAM(10);
    if (IN(11)) { for (int unit = (int)blockIdx.x; unit < 256; unit += F.G) hg_scan(F, unit); } SEAM(11);
    if (IN(12)) { for (int rep = 0; rep < NREP(12); ++rep) { if (rep) xcd_barrier(bar); phase_hg_carry(F); } } SEAM(12);
    if (IN(13)) { for (int rep = 0; rep < NREP(13); ++rep) { if (rep) xcd_barrier(bar); phase_hg_post(F); } } SEAM(13);
    if (IN(14)) {
        pg8::Gemm g{(const bf16*)(ws + WS_O1), (const bf16*)(ws + WS_WOUT1), D}; pg8::StaticOrder S; S.init(MR / 256, 4, F.G, (int)blockIdx.x);
        EpiResid E{F.out, HM, 31, F.out, HM};
        pg8::gemm_phase(F.wave, F.lds, g, S, E); } SEAM(14);
    if (IN(15)) { for (int rep = 0; rep < NREP(15); ++rep) { if (rep) xcd_barrier(bar); phase_route(F); } } SEAM(15);
    if (IN(16)) { phase_gather(F); } SEAM(16);
#define MOE_ORDER(S, ntp_, nN_, tile0_, slot0_, up_, nd_, take_) MoeOrder S; S.so.init((ntp_), (nN_), F.G, (int)blockIdx.x); S.tile0 = (tile0_); S.slot0 = (slot0_); S.up = (up_); S.te = (const LAS unsigned char*)(PERS + 16); S.nd = (nd_); S.take = (take_)
#define MOE_UP(S) do { pg8::Gemm g{(const bf16*)(ws + WS_XG), (const bf16*)(ws + WS_WM13), D / 2}; EpiSwiglu8 E{ws + WS_HMOE, DFFE, 1.f / (SC_X * SC_W13)}; pg8::gemm_phase<EpiSwiglu8, MoeOrder, true>(F.wave, F.lds, g, S, E); } while (0)
#define MOE_DOWN(S) do { pg8::Gemm g{(const bf16*)(ws + WS_HMOE), (const bf16*)(ws + WS_WM2), DFFE / 2}; EpiMoeDown E{(bf16*)(ws + WS_Y), (const float*)(ws + WS_ROUTE + RT_ROWGATE), 1.f / (SC_H * SC_W2)}; pg8::gemm_phase<EpiMoeDown, MoeOrder, true>(F.wave, F.lds, g, S, E); } while (0)
    if (IN(17)) { const LAS int* PERS = (const LAS int*)(F.lds + PERS_OFF); const int nl = PERS[8] - 256; MOE_ORDER(S, nl, 28, 256, 128, true, 0, 0); MOE_UP(S); } SEAM(17);
    if (IN(18)) { const LAS int* PERS = (const LAS int*)(F.lds + PERS_OFF); const int nl = PERS[8] - 256, nd = 4 * nl;
        { MOE_ORDER(S, nl, 4, 256, 128, false, 0, 0); MOE_DOWN(S); }
        { MOE_ORDER(S, 128, 28, 0, 0, true, nd, 10); MOE_UP(S); } } SEAM(18);
    if (IN(19)) { const LAS int* PERS = (const LAS int*)(F.lds + PERS_OFF); MOE_ORDER(S, 128, 4, 0, 0, false, 0, 0); MOE_DOWN(S); } SEAM(19);
    if (IN(20)) { const LAS int* PERS = (const LAS int*)(F.lds + PERS_OFF); MOE_ORDER(S, 128, 28, 128, 0, true, 0, 0); MOE_UP(S); } SEAM(20);
    if (IN(21)) { const LAS int* PERS = (const LAS int*)(F.lds + PERS_OFF); MOE_ORDER(S, 128, 4, 128, 0, false, 0, 0); MOE_DOWN(S); } SEAM(21);
    if (IN(22)) { phase_combine(F); }
#undef IN
#undef SEAM
}

extern "C" void kernel_launch(void* const* d_in, const int* in_sizes, int n_in, void* d_out, int out_size, void* d_ws, size_t ws_size, hipStream_t stream) {
    static int grid = 0;
    if (grid == 0) {
        if (n_in != 28 || out_size != MR * D || ws_size < WS_END) { fprintf(stderr, "kernel_launch: unexpected problem (n_in %d, out %d, ws %zu)\n", n_in, out_size, ws_size); grid = -1; return; }
        int dev = 0, cus = 0;
        if (hipGetDevice(&dev) != hipSuccess || hipDeviceGetAttribute(&cus, hipDeviceAttributeMultiprocessorCount, dev) != hipSuccess) { grid = -1; return; }
        if (hipFuncSetAttribute((const void*)mk_fwd, hipFuncAttributeMaxDynamicSharedMemorySize, LDS_BYTES) != hipSuccess) { grid = -1; return; }
        int per_cu = 0;
        if (hipOccupancyMaxActiveBlocksPerMultiprocessor(&per_cu, (const void*)mk_fwd, 512, LDS_BYTES) != hipSuccess || per_cu < 1) { (void)hipGetLastError(); }
        grid = cus;
    }
    if (grid < 0) return;
    (void)hipMemsetAsync((char*)d_ws + WS_CTL, 0, CTL_ZERO_BYTES, stream);
    Args a{};
    for (int i = 0; i < 28; ++i) a.in[i] = (const float*)d_in[i];
    a.out = (float*)d_out; a.ws = (unsigned char*)d_ws; a.dup = 1;
#if MK_PER_PHASE
    for (int p = 0; p < N_PHASES; ++p) { a.ph_lo = p; a.ph_hi = p + 1; hipLaunchKernelGGL(mk_fwd, dim3(grid), dim3(512), LDS_BYTES, stream, a); }
#else
    a.ph_lo = 0; a.ph_hi = N_PHASES;
    hipLaunchKernelGGL(mk_fwd, dim3(grid), dim3(512), LDS_BYTES, stream, a);
#endif
}
```

```cpp
#include <hip/hip_runtime.h>
#include <cstdio>
#include <cstdint>

#define GAS __attribute__((address_space(1)))
#define LAS __attribute__((address_space(3)))
typedef unsigned short bf16;
typedef unsigned v4u __attribute__((ext_vector_type(4)));
typedef unsigned v2u __attribute__((ext_vector_type(2)));
typedef float f32x2 __attribute__((ext_vector_type(2)));
typedef float f32x4 __attribute__((ext_vector_type(4)));
typedef float f32x16 __attribute__((ext_vector_type(16)));
typedef short bf16x8 __attribute__((ext_vector_type(8)));
typedef short s16x4_t __attribute__((ext_vector_type(4)));
typedef short bf16x4 __attribute__((ext_vector_type(4)));
typedef __bf16 hbf16x2 __attribute__((ext_vector_type(2)));
typedef GAS unsigned gu32;

constexpr int D = 1024, NB = 2, SEQ = 16384, NMETA = 16;
constexpr int MR = NB * SEQ;
constexpr int MROWS = MR + NB * NMETA;
constexpr int MP = 33024;
constexpr int LP = 16448;
constexpr int NCH = 257;
constexpr float EPS = 1e-6f;
constexpr int EIN = 3592, NPROJ0 = 3584, DFF = 2816, DFFE = 3584, NEXP = 8;

constexpr size_t MiB = 1u << 20;
constexpr size_t WS_CTL = 0, CTL_ZERO_BYTES = 32 * 1024;
constexpr size_t WS_HM = 1 * MiB;
constexpr size_t WS_BG = 2 * MiB;
constexpr size_t WS_ROUTE = 2 * MiB;
constexpr size_t WS_WIN0 = 4 * MiB, WS_WOUT0 = 11 * MiB, WS_W13 = 13 * MiB, WS_W2 = 24 * MiB, WS_WIN1 = 30 * MiB, WS_WOUT1 = 38 * MiB;
constexpr size_t WS_HN = 40 * MiB;
constexpr size_t WS_BIG = 105 * MiB;
constexpr size_t WS_END = 535 * MiB;
constexpr size_t WS_Q = WS_BIG, WS_K = WS_BIG + 33 * MiB, WS_VR = WS_BIG + 66 * MiB, WS_VT = WS_BIG + 99 * MiB, WS_BZ = WS_BIG + 132 * MiB;
constexpr size_t WS_CRAW = WS_BIG + 165 * MiB;
constexpr size_t WS_O = WS_CRAW;
constexpr size_t WS_SCAN0 = WS_BIG + 262 * MiB;
constexpr int DN_BLOB = 74240;
constexpr int DN_Q = 0, DN_W = 16384, DN_KT = 32768, DN_U = 49152, DN_QK = 65536, DN_GC = 73728;
static_assert(WS_SCAN0 + (size_t)NB * 4 * NCH * DN_BLOB <= WS_END, "scan0");
static_assert((size_t)NB * LP * 512 * 2 <= 33 * MiB && (size_t)NB * LP * 1536 * 2 <= 97 * MiB && (size_t)MP * 1024 * 2 <= 65 * MiB, "l0 map");
constexpr size_t WS_H0 = WS_BIG;
constexpr size_t WS_PROJ1 = WS_BIG;
constexpr size_t WS_SCAN1 = WS_BIG + 258 * MiB;
constexpr int HG_BLOB = 41472;
constexpr int HG_QG = 0, HG_ATT = 16384, HG_KDT = 24576, HG_DEC = 40960;
static_assert((size_t)MP * 4096 * 2 <= 258 * MiB && WS_SCAN1 + (size_t)NB * 8 * NCH * HG_BLOB <= WS_END, "l1 map");
constexpr size_t WS_O1 = WS_HN;
constexpr int HG_SC = 17, HG_NSC = 16;
constexpr size_t WS_SLOC = 4 * MiB;
constexpr size_t WS_SINT = 20 * MiB;
constexpr size_t WS_DECSC = 28 * MiB;
constexpr size_t WS_WM13 = WS_BIG, WS_WM2 = WS_BIG + 56 * MiB;
constexpr size_t WS_XG = WS_BIG + 84 * MiB;
constexpr int NROWS_MOE = 2 * MR + NEXP * 256;
constexpr size_t WS_Y = WS_BIG + 150 * MiB;
constexpr size_t WS_HMOE = WS_BIG + 282 * MiB;
constexpr int MOE_PASS_TILES = 128, MOE_H_TILES = 136;
constexpr float SC_X = 8.f, SC_W13 = 256.f, SC_H = 4.f, SC_W2 = 512.f;
static_assert(WS_WM2 + (size_t)NEXP * D * DFFE <= WS_XG && WS_XG + (size_t)NROWS_MOE * 1024 <= WS_Y && WS_Y + (size_t)NROWS_MOE * 2048 <= WS_HMOE && WS_HMOE + (size_t)MOE_H_TILES * 256 * DFFE <= WS_END, "moe map");
constexpr size_t RT_TOKINFO = 0;
constexpr size_t RT_WGCNT = 600 * 1024;
constexpr size_t RT_ROWGATE = 640 * 1024;
constexpr size_t RT_ROWTOK = 960 * 1024;
static_assert(RT_ROWTOK + (size_t)NROWS_MOE * 4 <= 2 * MiB && (size_t)MR * 16 <= RT_WGCNT && RT_ROWGATE + (size_t)NROWS_MOE * 4 <= RT_ROWTOK, "route map");

constexpr int CW_TMO = 0;
constexpr int CW_QHEAD = 64;
constexpr int CW_BAR = 4096;

constexpr int RING_BYTES = 131072;
constexpr int LDSCTL_OFF = RING_BYTES, MISC_OFF = LDSCTL_OFF + 320;
constexpr int PERS_OFF = RING_BYTES + 1024;
constexpr int PRIV_OFF = RING_BYTES + 2048;
constexpr int LDS_BYTES = 163840;

#define RLX_AGENT __ATOMIC_RELAXED, __HIP_MEMORY_SCOPE_AGENT
#define LDS_WAIT() asm volatile("s_waitcnt lgkmcnt(0)" ::: "memory")
#define VM_WAIT() asm volatile("s_waitcnt vmcnt(0)" ::: "memory")
__device__ __forceinline__ unsigned pk2(float lo, float hi) { f32x2 v = {lo, hi}; hbf16x2 b = __builtin_convertvector(v, hbf16x2); return __builtin_bit_cast(unsigned, b); }
__device__ __forceinline__ bf16 f2bf(float f) { return (bf16)(pk2(f, 0.f) & 0xffffu); }
__device__ __forceinline__ float bf2f(unsigned v) { return __uint_as_float(v << 16); }
__device__ __forceinline__ float bflo(unsigned w) { return __uint_as_float(w << 16); }
__device__ __forceinline__ float bfhi(unsigned w) { return __uint_as_float(w & 0xffff0000u); }
__device__ __forceinline__ float clamp8(float v) { return fminf(fmaxf(v, -448.f), 448.f); }
__device__ __forceinline__ unsigned pk4_fp8(float a, float b, float c, float d) { int w = 0; w = __builtin_amdgcn_cvt_pk_fp8_f32(clamp8(a), clamp8(b), w, false); w = __builtin_amdgcn_cvt_pk_fp8_f32(clamp8(c), clamp8(d), w, true); return (unsigned)w; }
__device__ __forceinline__ float wave_sum(float v) {
#pragma unroll
    for (int o = 1; o < 64; o <<= 1) v += __shfl_xor(v, o);
    return v;
}
__device__ __forceinline__ float fast_exp(float x) { return __builtin_amdgcn_exp2f(x * 1.4426950408889634f); }
__device__ __forceinline__ float sigmoidf_(float x) { return __builtin_amdgcn_rcpf(1.f + fast_exp(-x)); }
__device__ __forceinline__ float siluf_(float x) { return x * sigmoidf_(x); }
__device__ __forceinline__ int prow_of_r(int r) { return r < MR ? r + 64 * ((r >> 14) + 1) : ((r - MR) >> 4) * LP + 48 + ((r - MR) & 15); }
__device__ __forceinline__ int r_of_bp(int b, int pp) { return pp >= 64 ? b * SEQ + pp - 64 : MR + b * NMETA + pp - 48; }

#define XB_TMO      128
#define XB_XCNT(j)  (256  + 64 * (j))
#define XB_XSUB(j)  (1280 + 64 * (j))
#define XB_XGEN(j)  (2304 + 64 * (j))
#define XB_TOP      3328
#define XB_TOPGEN   3392
#define XCD_BAR_WORDS 3456
#define XB_SPIN_CAP (1u << 18)
__device__ __forceinline__ unsigned xb_ld(unsigned* p)              { return __hip_atomic_load(p, __ATOMIC_RELAXED, __HIP_MEMORY_SCOPE_AGENT); }
__device__ __forceinline__ unsigned xb_add(unsigned* p, unsigned v) { return __hip_atomic_fetch_add(p, v, __ATOMIC_RELAXED, __HIP_MEMORY_SCOPE_AGENT); }
__device__ __forceinline__ int lane_id_asm() { int l; asm volatile("v_mbcnt_lo_u32_b32 %0, -1, 0\n\tv_mbcnt_hi_u32_b32 %0, -1, %0" : "=&v"(l)); return l; }
#define LANE_ID() lane_id_asm()
__device__ __forceinline__ unsigned xb_xcc_id() { return (unsigned)__builtin_amdgcn_s_getreg((3 << 11) | 20) & 0xFu; }
#define XB_SPIN(cond, bar) do { unsigned _sp = 0; while (cond) { __builtin_amdgcn_s_sleep(1); \
    if ((++_sp & 255u) == 0u) { if (xb_ld(&(bar)[XB_TMO])) break; if (_sp > XB_SPIN_CAP) { atomicAdd(&(bar)[XB_TMO], 1u); break; } } } } while (0)
struct XcdBarrier { unsigned* bar; unsigned x; volatile LAS unsigned* st; int wv; };
__device__ __forceinline__ XcdBarrier xcd_barrier_post(unsigned* bar, volatile LAS unsigned* st, int wv) {
    XcdBarrier b; b.bar = bar; b.x = xb_xcc_id(); b.st = st; b.wv = wv;
    if (wv * 64 + LANE_ID() == 0) (void)xb_add(&bar[XB_XCNT(b.x)], 1u);
    return b;
}
__device__ __forceinline__ void xcd_barrier_complete(unsigned* bar, unsigned x, unsigned& nloc, unsigned& nx) {
    const unsigned G = gridDim.x * gridDim.y * gridDim.z;
    unsigned sum, cnt, mine, sp = 0u;
    for (;;) {
        sum = 0u; cnt = 0u; mine = 0u;
#pragma unroll
        for (unsigned j = 0; j < 16; ++j) { const unsigned c = xb_ld(&bar[XB_XCNT(j)]); sum += c; cnt += (c > 0u) ? 1u : 0u; mine = (j == x) ? c : mine; }
        if (sum == G) break;
        __builtin_amdgcn_s_sleep(1);
        if ((++sp & 255u) == 0u) { if (xb_ld(&bar[XB_TMO])) break; if (sp > XB_SPIN_CAP) { atomicAdd(&bar[XB_TMO], 1u); break; } }
    }
    nloc = mine > 0u ? mine : 1u; nx = cnt > 0u ? cnt : 1u;
}
__device__ __forceinline__ void xcd_barrier(const XcdBarrier& b) {
    asm volatile("s_waitcnt vmcnt(0)" ::: "memory");
    __syncthreads();
    if (b.wv * 64 + LANE_ID() == 0) {
        unsigned* bar = b.bar;
        __builtin_amdgcn_s_waitcnt(0);
        unsigned nloc = b.st[0], nx = b.st[1];
        if (nloc == 0u) { xcd_barrier_complete(bar, b.x, nloc, nx); b.st[0] = nloc; b.st[1] = nx; }
        const unsigned old = xb_add(&bar[XB_XSUB(b.x)], 1u);
        const unsigned gen = old / nloc;
        if (old + 1u == (gen + 1u) * nloc) {
            __builtin_amdgcn_fence(__ATOMIC_RELEASE, "agent");
            asm volatile("s_waitcnt vmcnt(0)" ::: "memory");
            const unsigned og = xb_add(&bar[XB_TOP], 1u);
            const unsigned tg = og / nx;
            if (og + 1u == (tg + 1u) * nx) xb_add(&bar[XB_TOPGEN], 1u);
            else XB_SPIN(xb_ld(&bar[XB_TOPGEN]) == tg, bar);
            __builtin_amdgcn_fence(__ATOMIC_ACQUIRE, "agent");
            xb_add(&bar[XB_XGEN(b.x)], 1u);
            asm volatile("s_waitcnt vmcnt(0)" ::: "memory");
        } else {
            XB_SPIN(xb_ld(&bar[XB_XGEN(b.x)]) == gen, bar);
            __builtin_amdgcn_fence(__ATOMIC_ACQUIRE, "agent");
            asm volatile("s_waitcnt vmcnt(0)" ::: "memory");
        }
    }
    __syncthreads();
}

#ifndef PG8_ALIGN
#define PG8_ALIGN 1
#endif
typedef int v4i_t __attribute__((ext_vector_type(4)));
typedef int v8i_t __attribute__((ext_vector_type(8)));
namespace pg8 {
constexpr int BM = 256, BK = 64, HALF = 128, HTB = HALF * BK * 2, NXCD = 8, WGM = 8;
__host__ __device__ __forceinline__ int lds_byte(int r, int c) { const int st = (r >> 4) * 2 + (c >> 5), rr = r & 15, cc = c & 31, ob = rr * 64 + cc * 2; return st * 1024 + (ob ^ (((ob >> 9) & 1) << 5)); }
__host__ __device__ __forceinline__ void stage_rc(int b, int& R, int& C) { const int st = b / 1024, sb = b % 1024, swz = sb ^ (((sb >> 9) & 1) << 5); R = (st >> 1) * 16 + swz / 64; C = (st & 1) * 32 + (swz % 64) / 2; }
__host__ __device__ __forceinline__ int perm32(int rho) { const int n = rho >> 4, i = rho & 15; return 8 * (i >> 2) + 4 * n + (i & 3); }

struct Unit { int pm, pn, arow, brow, orow, nrow; };
struct Gemm { const bf16* A; const bf16* Bt; int K; };

struct StaticOrder {
    int nM, nN, nwg, G, c, mvalid;
    __device__ void init(int nM_, int nN_, int G_, int c_, int mvalid_ = 1 << 30) { nM = nM_; nN = nN_; nwg = nM * nN; G = G_; c = c_; mvalid = mvalid_; }
    __device__ bool next(int i, Unit& u) const { return map((long)i * G + c, u); }
    __device__ bool map(long L, Unit& u) const {
        if (L >= nwg) return false;
        int wgid = (int)L; { const int q = nwg / NXCD, r = nwg % NXCD, xcd = wgid % NXCD, off = wgid / NXCD; wgid = (xcd < r ? xcd * (q + 1) : r * (q + 1) + (xcd - r) * q) + off; }
        const int nig = WGM * nN, gid = wgid / nig, fm = gid * WGM, gsz = (nM - fm) < WGM ? (nM - fm) : WGM;
        u.pm = fm + ((wgid % nig) % gsz); u.pn = (wgid % nig) / gsz; u.arow = u.pm * BM; u.brow = u.pn * BM; u.orow = u.pm * BM; { const int left = mvalid - u.pm * BM; u.nrow = left < BM ? left : BM; } return true;
    }
};

template <class Epi, class Sched, bool FP8 = false>
__device__ __forceinline__ void gemm_phase(const int wv, LAS unsigned char* lds, const Gemm g, const Sched& S, const Epi& E) {
    int tz_ = wv * 64 + LANE_ID(); asm volatile("" : "+v"(tz_));
    const int tid = tz_, wid = __builtin_amdgcn_readfirstlane(tid >> 6), lane = tid & 63, wr = wid >> 2, wc = wid & 3, fr = lane & 15, fq = lane >> 4;
    const int K = g.K, nt = K / BK;
    unsigned voffA[2], voffB[2];
#pragma unroll
    for (int i = 0; i < 2; ++i) { int R, C; stage_rc(tid * 16 + i * 8192, R, C); const int Rb = (R & ~31) + perm32(R & 31);
        voffA[i] = (unsigned)(R * K + C) * 2u; voffB[i] = (unsigned)(Rb * K + C) * 2u; }
    const size_t kstep = (size_t)(BK * 2);
    const size_t hstep = (size_t)HALF * K * 2;
    const size_t rstep = (size_t)K * 2;
    const unsigned ldsw = (unsigned)wid * 1024u;
    const int aoff = lds_byte(wr * 64 + fr, fq * 8), boff = lds_byte(wc * 32 + fr, fq * 8);
#define PG8_SA(b, h) (((b) * 2 + (h)) * HTB)
#define PG8_SB(b, h) ((4 + (b) * 2 + (h)) * HTB)
#define PG8_STAGE(bufoff, gbase, voff) do { _Pragma("unroll") for (int _i = 0; _i < 2; ++_i) \
        __builtin_amdgcn_global_load_lds((const unsigned*)((const char*)(gbase) + (voff)[_i]), (LAS unsigned*)(lds + (bufoff) + ldsw + _i * 8192), 16, 0, 0); } while (0)
#define PG8_LD8(base_) __builtin_shufflevector(*(const LAS v4i_t*)(base_), *(const LAS v4i_t*)((base_) + 1024), 0, 1, 2, 3, 4, 5, 6, 7)
#define PG8_LDA(dst, b, h) do { if constexpr (FP8) { _Pragma("unroll") for (int m = 0; m < 4; ++m) dst##8[m] = PG8_LD8(lds + PG8_SA(b, h) + aoff + m * 2048); } \
        else { _Pragma("unroll") for (int m = 0; m < 4; ++m) _Pragma("unroll") for (int k = 0; k < 2; ++k) dst[m][k] = *(const LAS bf16x8*)(lds + PG8_SA(b, h) + aoff + m * 2048 + k * 1024); } } while (0)
#define PG8_LDB(dst, b, h) do { if constexpr (FP8) { _Pragma("unroll") for (int n = 0; n < 2; ++n) dst##8[n] = PG8_LD8(lds + PG8_SB(b, h) + boff + n * 2048); } \
        else { _Pragma("unroll") for (int n = 0; n < 2; ++n) _Pragma("unroll") for (int k = 0; k < 2; ++k) dst[n][k] = *(const LAS bf16x8*)(lds + PG8_SB(b, h) + boff + n * 2048 + k * 1024); } } while (0)
#define PG8_MMA(ai, bj, At, Bt) do { __builtin_amdgcn_s_setprio(1); \
        if constexpr (FP8) { _Pragma("unroll") for (int m = 0; m < 4; ++m) _Pragma("unroll") for (int n = 0; n < 2; ++n) \
            acc[ai][bj][m][n] = __builtin_amdgcn_mfma_scale_f32_16x16x128_f8f6f4(Bt##8[n], At##8[m], acc[ai][bj][m][n], 0, 0, 0, 0x7F7F7F7F, 0, 0x7F7F7F7F); \
            _Pragma("unroll") for (int m = 0; m < 4; ++m) _Pragma("unroll") for (int n = 0; n < 2; ++n) asm volatile("" : "+v"(acc[ai][bj][m][n])); }     \
        else { _Pragma("unroll") for (int m = 0; m < 4; ++m) _Pragma("unroll") for (int n = 0; n < 2; ++n) _Pragma("unroll") for (int k = 0; k < 2; ++k) \
            acc[ai][bj][m][n] = __builtin_amdgcn_mfma_f32_16x16x32_bf16(Bt[n][k], At[m][k], acc[ai][bj][m][n], 0, 0, 0); } \
        __builtin_amdgcn_s_setprio(0); } while (0)
#define PG8_MM(ai, bj, At, Bt) do { if (full || ((ai) == 0 && wr == 0)) PG8_MMA(ai, bj, At, Bt); } while (0)
#define PG8_WAIT_V(n) asm volatile("s_waitcnt vmcnt(" #n ")" ::: "memory")
#define PG8_WAIT_L(n) asm volatile("s_waitcnt lgkmcnt(" #n ")" ::: "memory")
#define PG8_BAR __builtin_amdgcn_s_barrier()
#define PG8_SCHED __builtin_amdgcn_sched_barrier(0)
    Unit cur, nxt; int ui = 0;
    if (!S.next(0, cur)) return;
    f32x4 acc[2][2][4][2];
#pragma unroll
    for (int a = 0; a < 2; ++a)
#pragma unroll
        for (int b = 0; b < 2; ++b)
#pragma unroll
            for (int m = 0; m < 4; ++m)
#pragma unroll
                for (int n = 0; n < 2; ++n) acc[a][b][m][n] = (f32x4){0.f, 0.f, 0.f, 0.f};
    bf16x8 At[4][2], B0[2][2], B1[2][2]; v8i_t At8[4], B08[2], B18[2];
    const char* cA = (const char*)g.A + (size_t)cur.arow * rstep; const char* cB = (const char*)g.Bt + (size_t)cur.brow * rstep;
    PG8_STAGE(PG8_SB(0, 0), cB, voffB); PG8_STAGE(PG8_SB(0, 1), cB + hstep, voffB); PG8_STAGE(PG8_SA(0, 0), cA, voffA); PG8_STAGE(PG8_SA(0, 1), cA + hstep, voffA);
    if (wr == 1) PG8_BAR;
    PG8_WAIT_V(2); PG8_BAR;
    PG8_STAGE(PG8_SB(1, 0), cB + kstep, voffB); PG8_STAGE(PG8_SA(1, 0), cA + kstep, voffA); PG8_STAGE(PG8_SB(1, 1), cB + hstep + kstep, voffB);
    PG8_WAIT_V(6); PG8_BAR;
    for (;;) {
        const bool has_next = S.next(ui + 1, nxt);
        const char* nA = has_next ? (const char*)g.A + (size_t)nxt.arow * rstep : cA; const char* nB = has_next ? (const char*)g.Bt + (size_t)nxt.brow * rstep : cB;
        const bool full = cur.nrow > 32;
        for (int t = 0; t < nt; t += 2) {
            const bool last = (t == nt - 2);
            const char* a1 = cA + (size_t)(t + 1) * kstep;
            const char* a2 = last ? nA : cA + (size_t)(t + 2) * kstep; const char* b2 = last ? nB : cB + (size_t)(t + 2) * kstep;
            const char* a3 = a2 + kstep; const char* b3 = b2 + kstep;
            PG8_LDB(B0, 0, 0); PG8_LDB(B1, 0, 1); PG8_SCHED; PG8_LDA(At, 0, 0); PG8_STAGE(PG8_SA(1, 1), a1 + hstep, voffA);
            PG8_WAIT_V(8); PG8_WAIT_L(0); PG8_BAR; PG8_MM(0, 0, At, B0); PG8_MM(0, 1, At, B1); PG8_BAR; PG8_SCHED;
            PG8_LDA(At, 0, 1); PG8_STAGE(PG8_SB(0, 0), b2, voffB); PG8_STAGE(PG8_SB(0, 1), b2 + hstep, voffB); PG8_STAGE(PG8_SA(0, 0), a2, voffA);
            PG8_WAIT_V(8); PG8_WAIT_L(0); PG8_BAR; PG8_MM(1, 0, At, B0); PG8_MM(1, 1, At, B1); PG8_BAR; PG8_SCHED;
            PG8_LDB(B0, 1, 0); PG8_LDB(B1, 1, 1); PG8_SCHED; PG8_LDA(At, 1, 0); PG8_STAGE(PG8_SA(0, 1), a2 + hstep, voffA);
            PG8_WAIT_V(8); PG8_WAIT_L(0); PG8_BAR; PG8_MM(0, 0, At, B0); PG8_MM(0, 1, At, B1); PG8_BAR; PG8_SCHED;
            PG8_LDA(At, 1, 1); PG8_STAGE(PG8_SB(1, 0), b3, voffB); PG8_STAGE(PG8_SB(1, 1), b3 + hstep, voffB); PG8_STAGE(PG8_SA(1, 0), a3, voffA);
            PG8_WAIT_V(8); PG8_WAIT_L(0); PG8_BAR; PG8_MM(1, 0, At, B0); PG8_MM(1, 1, At, B1); PG8_BAR; PG8_SCHED;
        }
#if PG8_ALIGN
        if (wr == 0) PG8_BAR;
#endif
        E(acc, cur, wr, wc, fr, fq);
        if (!has_next) break;
#pragma unroll
        for (int a = 0; a < 2; ++a)
#pragma unroll
            for (int b = 0; b < 2; ++b)
#pragma unroll
                for (int m = 0; m < 4; ++m)
#pragma unroll
                    for (int n = 0; n < 2; ++n) acc[a][b][m][n] = (f32x4){0.f, 0.f, 0.f, 0.f};
        cur = nxt; cA = nA; cB = nB; ++ui;
#if PG8_ALIGN
        if (wr == 1) PG8_BAR;
#endif
    }
    PG8_WAIT_V(0);
#if !PG8_ALIGN
    if (wr == 0) PG8_BAR;
#endif
    PG8_BAR;
#undef PG8_SA
#undef PG8_SB
#undef PG8_STAGE
#undef PG8_LDA
#undef PG8_LDB
#undef PG8_LD8
#undef PG8_MMA
#undef PG8_MM
#undef PG8_WAIT_V
#undef PG8_WAIT_L
#undef PG8_BAR
#undef PG8_SCHED
}
}
using pg8::Unit;
typedef f32x4 Acc[2][2][4][2];

__device__ __forceinline__ v4u pack8(const f32x4& a, const f32x4& b) { v4u w; w.x = pk2(a[0], a[1]); w.y = pk2(a[2], a[3]); w.z = pk2(b[0], b[1]); w.w = pk2(b[2], b[3]); return w; }

struct EpiProj0 {
    bf16 *Q, *K, *VR, *CR, *BZ;
    __device__ __forceinline__ void operator()(const Acc& acc, const Unit& u, int wr, int wc, int fr, int fq) const {
        const int pn = u.pn; bf16* base; int ld, c0;
        if (pn < 2) { base = Q; ld = 512; c0 = pn * 256; } else if (pn < 4) { base = K; ld = 512; c0 = (pn - 2) * 256; } else if (pn < 6) { base = VR; ld = 512; c0 = (pn - 4) * 256; }
        else if (pn < 12) { base = CR; ld = 1536; c0 = (pn - 6) * 256; } else { base = BZ; ld = 512; c0 = (pn - 12) * 256; }
        c0 += wc * 32 + 8 * fq;
#pragma unroll
        for (int ai = 0; ai < 2; ++ai)
#pragma unroll
            for (int m = 0; m < 4; ++m) { const int r = u.orow + ai * 128 + wr * 64 + m * 16 + fr;
                if (r < MROWS) { bf16* rowp = base + (size_t)prow_of_r(r) * ld + c0;
#pragma unroll
                    for (int bj = 0; bj < 2; ++bj) *(v4u*)(rowp + bj * 128) = pack8(acc[ai][bj][m][0], acc[ai][bj][m][1]); } }
    }
};
struct EpiBf16 {
    bf16* O; int ld;
    __device__ __forceinline__ void operator()(const Acc& acc, const Unit& u, int wr, int wc, int fr, int fq) const {
        const int c0 = u.pn * 256 + wc * 32 + 8 * fq;
#pragma unroll
        for (int ai = 0; ai < 2; ++ai)
#pragma unroll
            for (int m = 0; m < 4; ++m) { bf16* rowp = O + (size_t)(u.orow + ai * 128 + wr * 64 + m * 16 + fr) * ld + c0;
#pragma unroll
                for (int bj = 0; bj < 2; ++bj) *(v4u*)(rowp + bj * 128) = pack8(acc[ai][bj][m][0], acc[ai][bj][m][1]); }
    }
};
struct EpiSwiglu {
    bf16* H; int ld;
    __device__ __forceinline__ void operator()(const Acc& acc, const Unit& u, int wr, int wc, int fr, int fq) const {
        const int c0 = u.pn * 128 + wc * 32 + 8 * fq;
#pragma unroll
        for (int ai = 0; ai < 2; ++ai)
#pragma unroll
            for (int m = 0; m < 4; ++m) { bf16* rowp = H + (size_t)(u.orow + ai * 128 + wr * 64 + m * 16 + fr) * ld + c0;
                f32x4 h0, h1;
#pragma unroll
                for (int j = 0; j < 4; ++j) { h0[j] = siluf_(acc[ai][0][m][0][j]) * acc[ai][1][m][0][j]; h1[j] = siluf_(acc[ai][0][m][1][j]) * acc[ai][1][m][1][j]; }
                *(v4u*)rowp = pack8(h0, h1); }
    }
};
struct EpiSwiglu8 {
    unsigned char* H; int ld; float inv;
    __device__ __forceinline__ void operator()(const Acc& acc, const Unit& u, int wr, int wc, int fr, int fq) const {
        const int c0 = u.pn * 128 + wc * 32 + 8 * fq;
#pragma unroll
        for (int ai = 0; ai < 2; ++ai)
#pragma unroll
            for (int m = 0; m < 4; ++m) { unsigned char* rowp = H + (size_t)(u.orow + ai * 128 + wr * 64 + m * 16 + fr) * ld + c0;
                float h[8];
#pragma unroll
                for (int j = 0; j < 4; ++j) { h[j] = SC_H * siluf_(acc[ai][0][m][0][j] * inv) * (acc[ai][1][m][0][j] * inv); h[4 + j] = SC_H * siluf_(acc[ai][0][m][1][j] * inv) * (acc[ai][1][m][1][j] * inv); }
                *(v2u*)rowp = (v2u){pk4_fp8(h[0], h[1], h[2], h[3]), pk4_fp8(h[4], h[5], h[6], h[7])}; }
    }
};
struct EpiResid {
    const float* src_real; const float* src_meta; int meta_mask; float* dst_real; float* dst_meta;
    __device__ __forceinline__ void operator()(const Acc& acc, const Unit& u, int wr, int wc, int fr, int fq) const {
        const int c0 = u.pn * 256 + wc * 32 + 8 * fq;
#pragma unroll
        for (int ai = 0; ai < 2; ++ai)
#pragma unroll
            for (int m = 0; m < 4; ++m) { const int r = u.orow + ai * 128 + wr * 64 + m * 16 + fr;
                if (r < MROWS) {
                    const float* s = (r < MR) ? src_real + (size_t)r * D : src_meta + (size_t)((r - MR) & meta_mask) * D;
                    float* d = (r < MR) ? dst_real + (size_t)r * D : dst_meta + (size_t)(r - MR) * D;
#pragma unroll
                    for (int bj = 0; bj < 2; ++bj) {
                        const f32x4 s0 = *(const f32x4*)(s + c0 + bj * 128), s1 = *(const f32x4*)(s + c0 + bj * 128 + 4);
                        *(f32x4*)(d + c0 + bj * 128) = s0 + acc[ai][bj][m][0]; *(f32x4*)(d + c0 + bj * 128 + 4) = s1 + acc[ai][bj][m][1]; } } }
    }
};
struct EpiMoeDown {
    bf16* Y; const float* rowgate; float inv;
    __device__ __forceinline__ void operator()(const Acc& acc, const Unit& u, int wr, int wc, int fr, int fq) const {
        const int c0 = u.pn * 256 + wc * 32 + 8 * fq;
#pragma unroll
        for (int ai = 0; ai < 2; ++ai)
#pragma unroll
            for (int m = 0; m < 4; ++m) { const int r = u.orow + ai * 128 + wr * 64 + m * 16 + fr; const float gt = rowgate[r] * inv;
                bf16* rowp = Y + (size_t)r * D + c0;
#pragma unroll
                for (int bj = 0; bj < 2; ++bj) *(v4u*)(rowp + bj * 128) = pack8(acc[ai][bj][m][0] * gt, acc[ai][bj][m][1] * gt); }
    }
};

struct InPtrs { const __attribute__((address_space(4))) unsigned long long* base;
    __device__ __forceinline__ const float* operator[](int i) const { return (const float*)base[i]; } };
struct Frame {
    LAS unsigned char* lds;
    volatile LAS unsigned* MISC;
    gu32* ctl;
    unsigned char* ws;
    int tid, lane, wave, vcu, G;
    InPtrs in;
    float* out;
};
enum { I_X = 0, I_META, I_LB, I_MIXN, I_FFNN, I_EWIN, I_AQG, I_AKG, I_LQ1, I_LK1, I_LQ2, I_LK2, I_ASUB, I_BCONV, I_BALOG, I_BDT, I_BOUTG, I_EWOUT,
       I_W1, I_W3, I_W2, I_OWIN, I_COUTG, I_OWOUT, I_ROUTER, I_MW1, I_MW3, I_MW2 };

template <int ILV>
__device__ __forceinline__ void transpose_item(const float* W, int ldw, int K, int N, bf16* WT, int row_off, LAS float* scr, int item, int lane) {
    const int nblk = N / 32, kb = item / nblk, nb = item % nblk, k0 = 64 * kb, n0 = 32 * nb;
    float wv_[32];
#pragma unroll
    for (int i = 0; i < 32; ++i) wv_[i] = W[(size_t)(k0 + 2 * i + (lane >> 5)) * ldw + n0 + (lane & 31)];
#pragma unroll
    for (int i = 0; i < 32; ++i) scr[(2 * i + (lane >> 5)) * 33 + (lane & 31)] = wv_[i];
    LDS_WAIT(); asm volatile("" ::: "memory");
    const int c = lane & 7;
#pragma unroll
    for (int j = 0; j < 4; ++j) { const int n = (lane >> 3) + 8 * j; const LAS float* s = scr + (8 * c) * 33 + n;
        v4u o; o.x = pk2(s[0 * 33], s[1 * 33]); o.y = pk2(s[2 * 33], s[3 * 33]); o.z = pk2(s[4 * 33], s[5 * 33]); o.w = pk2(s[6 * 33], s[7 * 33]);
        const int nn = n0 + n; const int orow = ILV ? ((nn >> 7) * 256 + (nn & 127) + row_off) : (row_off + nn);
        *(GAS v4u*)(WT + (size_t)orow * K + k0 + 8 * c) = o; }
    LDS_WAIT(); asm volatile("" ::: "memory");
}

template <int ILV>
__device__ __forceinline__ void transpose_item_fp8(const float* W, int ldw, int K, int N, unsigned char* WT8, int row_off, LAS float* scr, int item, int lane, float scl) {
    const int nblk = N / 32, kb = item / nblk, nb = item % nblk, k0 = 64 * kb, n0 = 32 * nb;
    float wv_[32];
#pragma unroll
    for (int i = 0; i < 32; ++i) wv_[i] = W[(size_t)(k0 + 2 * i + (lane >> 5)) * ldw + n0 + (lane & 31)];
#pragma unroll
    for (int i = 0; i < 32; ++i) scr[(2 * i + (lane >> 5)) * 33 + (lane & 31)] = wv_[i] * scl;
    LDS_WAIT(); asm volatile("" ::: "memory");
    const int c = lane & 7;
#pragma unroll
    for (int j = 0; j < 4; ++j) { const int n = (lane >> 3) + 8 * j; const LAS float* s = scr + (8 * c) * 33 + n;
        v2u o; o.x = pk4_fp8(s[0 * 33], s[1 * 33], s[2 * 33], s[3 * 33]); o.y = pk4_fp8(s[4 * 33], s[5 * 33], s[6 * 33], s[7 * 33]);
        const int nn = n0 + n; const int orow = ILV ? ((nn >> 7) * 256 + (nn & 127) + row_off) : (row_off + nn);
        *(GAS v2u*)(WT8 + (size_t)orow * K + k0 + 8 * c) = o; }
    LDS_WAIT(); asm volatile("" ::: "memory");
}
__device__ __forceinline__ void rms_row(const float* xrow, const float* gain, int lane, float (&y)[16]) {
    const f32x4* xr = (const f32x4*)xrow + lane; const f32x4* gr = (const f32x4*)gain + lane;
    f32x4 v[4]; float s = 0.f;
#pragma unroll
    for (int j = 0; j < 4; ++j) { v[j] = xr[64 * j]; s += (v[j][0] * v[j][0] + v[j][1] * v[j][1]) + (v[j][2] * v[j][2] + v[j][3] * v[j][3]); }
    const float rstd = 1.f / sqrtf(wave_sum(s) * (1.f / D) + EPS);
#pragma unroll
    for (int j = 0; j < 4; ++j) { const f32x4 gg = gr[64 * j];
#pragma unroll
        for (int c = 0; c < 4; ++c) y[4 * j + c] = v[j][c] * rstd * gg[c]; }
}
__device__ __forceinline__ void row_load(const float* xrow, int lane, f32x4 (&v)[4]) { const f32x4* xr = (const f32x4*)xrow + lane;
#pragma unroll
    for (int j = 0; j < 4; ++j) v[j] = xr[64 * j]; }
__device__ __forceinline__ void rms_finish(const f32x4 (&v)[4], const float* gain, int lane, float (&y)[16]) { const f32x4* gr = (const f32x4*)gain + lane; float s = 0.f;
#pragma unroll
    for (int j = 0; j < 4; ++j) s += (v[j][0] * v[j][0] + v[j][1] * v[j][1]) + (v[j][2] * v[j][2] + v[j][3] * v[j][3]);
    const float rstd = __builtin_amdgcn_rsqf(wave_sum(s) * (1.f / D) + EPS);
#pragma unroll
    for (int j = 0; j < 4; ++j) { const f32x4 gg = gr[64 * j];
#pragma unroll
        for (int c = 0; c < 4; ++c) y[4 * j + c] = v[j][c] * rstd * gg[c]; } }
__device__ __forceinline__ void rms_finish_exact(const f32x4 (&v)[4], const float* gain, int lane, float (&y)[16]) { const f32x4* gr = (const f32x4*)gain + lane; float s = 0.f;
#pragma unroll
    for (int j = 0; j < 4; ++j) s += (v[j][0] * v[j][0] + v[j][1] * v[j][1]) + (v[j][2] * v[j][2] + v[j][3] * v[j][3]);
    const float rstd = 1.f / sqrtf(wave_sum(s) * (1.f / D) + EPS);
#pragma unroll
    for (int j = 0; j < 4; ++j) { const f32x4 gg = gr[64 * j];
#pragma unroll
        for (int c = 0; c < 4; ++c) y[4 * j + c] = v[j][c] * rstd * gg[c]; } }
__device__ __forceinline__ void store_row_bf16(bf16* orow, int lane, const float (&y)[16]) {
    unsigned long long* o8 = (unsigned long long*)orow + lane;
#pragma unroll
    for (int j = 0; j < 4; ++j) o8[64 * j] = (unsigned long long)pk2(y[4 * j], y[4 * j + 1]) | ((unsigned long long)pk2(y[4 * j + 2], y[4 * j + 3]) << 32);
}

__device__ __forceinline__ float sum4(float v) {
    v += __builtin_bit_cast(float, __builtin_amdgcn_update_dpp(0, __builtin_bit_cast(int, v), 0xB1, 0xf, 0xf, true));
    v += __builtin_bit_cast(float, __builtin_amdgcn_update_dpp(0, __builtin_bit_cast(int, v), 0x4E, 0xf, 0xf, true));
    return v;
}
__device__ __forceinline__ float sum8(float v) {
    v = sum4(v);
    v += __builtin_bit_cast(float, __builtin_amdgcn_update_dpp(0, __builtin_bit_cast(int, v), 0x141, 0xf, 0xf, true));
    return v;
}

__device__ __forceinline__ void phase_prologue(Frame& F) {
    int tz_ = F.wave * 64 + LANE_ID(); asm volatile("" : "+v"(tz_)); const int tid = tz_, lane = tz_ & 63, wave = __builtin_amdgcn_readfirstlane(tz_ >> 6); (void)tid; (void)lane; (void)wave;

    LAS float* scr = (LAS float*)(F.lds + wave * 8448);
    const int gw = F.vcu * 8 + wave, NGW = F.G * 8;
    bf16* WIN0 = (bf16*)(F.ws + WS_WIN0); bf16* WOUT0 = (bf16*)(F.ws + WS_WOUT0); bf16* W13 = (bf16*)(F.ws + WS_W13); bf16* W2 = (bf16*)(F.ws + WS_W2);
    bf16* WIN1 = (bf16*)(F.ws + WS_WIN1); bf16* WOUT1 = (bf16*)(F.ws + WS_WOUT1);
    constexpr int I_A = 16 * 112, I_B = 16 * 32, I_C = 16 * 88, I_D = 44 * 32, I_E = 16 * 128, I_F = 16 * 32;
    constexpr int NIT = I_A + I_B + 2 * I_C + I_D + I_E + I_F;
    int it = gw; const int nitw = (NIT - gw + NGW - 1) / NGW; int done = 0;
#define PR_ITEMS(upto) do { while (done < (upto) && it < NIT) { int r = it; \
        if (r < I_A) transpose_item<0>(F.in[I_EWIN], EIN, D, NPROJ0, WIN0, 0, scr, r, lane); \
        else if ((r -= I_A) < I_B) transpose_item<0>(F.in[I_EWOUT], D, D, D, WOUT0, 0, scr, r, lane); \
        else if ((r -= I_B) < I_C) transpose_item<1>(F.in[I_W1], DFF, D, DFF, W13, 0, scr, r, lane); \
        else if ((r -= I_C) < I_C) transpose_item<1>(F.in[I_W3], DFF, D, DFF, W13, 128, scr, r, lane); \
        else if ((r -= I_C) < I_D) transpose_item<0>(F.in[I_W2], D, DFF, D, W2, 0, scr, r, lane); \
        else if ((r -= I_D) < I_E) transpose_item<0>(F.in[I_OWIN], 4096, D, 4096, WIN1, 0, scr, r, lane); \
        else transpose_item<0>(F.in[I_OWOUT], D, D, D, WOUT1, 0, scr, r - I_E, lane); \
        it += NGW; ++done; } } while (0)
    LAS float* WsT = (LAS float*)(F.lds + 69632);
    for (int k = tid; k < D; k += 512) { const f32x4* p = (const f32x4*)(F.in[I_EWIN] + (size_t)k * EIN + NPROJ0); const f32x4 a = p[0], c = p[1];
        WsT[0 * D + k] = a[0]; WsT[1 * D + k] = a[1]; WsT[2 * D + k] = a[2]; WsT[3 * D + k] = a[3]; WsT[4 * D + k] = c[0]; WsT[5 * D + k] = c[1]; WsT[6 * D + k] = c[2]; WsT[7 * D + k] = c[3]; }
    __syncthreads();
    bf16* HN = (bf16*)(F.ws + WS_HN); float* BG = (float*)(F.ws + WS_BG);
    const float* gain = F.in[I_MIXN];
    float alog[4], dtb[4];
#pragma unroll
    for (int h = 0; h < 4; ++h) { alog[h] = F.in[I_BALOG][h]; dtb[h] = F.in[I_BDT][h]; }
    const float dtb_l = F.in[I_BDT][lane & 3], nega_l = -expf(F.in[I_BALOG][lane & 3]);
    int nrow_done = 0; const int nrows_w = (MROWS - gw + NGW - 1) / NGW;
    for (int r = gw; r < MROWS; r += NGW) {
        const float* src = (r < MR) ? F.in[I_X] + (size_t)r * D : F.in[I_META] + (size_t)((r - MR) & 15) * D;
        float y[16]; rms_row(src, gain, lane, y);
        store_row_bf16(HN + (size_t)r * D, lane, y);
        float d8[8];
#pragma unroll
        for (int j = 0; j < 8; ++j) { float s = 0.f;
#pragma unroll
            for (int jj = 0; jj < 4; ++jj) { const f32x4 w = *(const LAS f32x4*)(WsT + j * D + 4 * lane + 256 * jj); s += y[4 * jj] * w[0] + y[4 * jj + 1] * w[1] + y[4 * jj + 2] * w[2] + y[4 * jj + 3] * w[3]; }
            d8[j] = wave_sum(s); }
        {
            const int j8 = lane & 7; float dsel = d8[0];
#pragma unroll
            for (int k = 1; k < 8; ++k) dsel = (j8 == k) ? d8[k] : dsel;
            const float sg = 1.f / (1.f + expf(-dsel));
            const float xx = dsel + dtb_l; const float sp = fmaxf(xx, 0.f) + log1pf(expf(-fabsf(xx)));
            const float val = (j8 < 4) ? sg : nega_l * sp;
            if (lane < 8) BG[(size_t)prow_of_r(r) * 8 + lane] = val; }
        ++nrow_done; PR_ITEMS((nrow_done * nitw) / nrows_w);
    }
    PR_ITEMS(nitw);
#undef PR_ITEMS
}

__device__ __forceinline__ void qk_prep(Frame& F) {
    int tz_ = F.wave * 64 + LANE_ID(); asm volatile("" : "+v"(tz_)); const int tid = tz_, lane = tz_ & 63, wave = __builtin_amdgcn_readfirstlane(tz_ >> 6); (void)tid; (void)lane; (void)wave;

    int nx = (NB * 4 * NCH) % F.G; if (nx * 4 > F.G) nx = 0;
    if (F.vcu < nx) return;
    const int gw = (F.vcu - nx) * 8 + wave, NGW = (F.G - nx) * 8;
    bf16* Q = (bf16*)(F.ws + WS_Q); bf16* K = (bf16*)(F.ws + WS_K);
    const int hc = lane >> 2, sub = lane & 3;
    float gn[16];
    { const float* gp = (hc < 8 ? F.in[I_AQG] : F.in[I_AKG]) + sub * 16;
#pragma unroll
      for (int i = 0; i < 16; ++i) gn[i] = gp[i]; }
    float invf[8];
#pragma unroll
    for (int i = 0; i < 8; ++i) invf[i] = powf(500000.0f, -(float)i * 0.125f);
    const float qscale = (hc < 8) ? 0.125f * 1.4426950408889634f : 1.0f;
    for (int idx = gw; idx < NB * LP; idx += NGW) {
        const int pp = idx % LP;
        bf16* rowp = (hc < 8 ? Q : K) + (size_t)idx * 512 + (hc & 7) * 64 + sub * 16;
        if (pp < 48) { *(v4u*)rowp = (v4u){0u, 0u, 0u, 0u}; *(v4u*)(rowp + 8) = (v4u){0u, 0u, 0u, 0u}; *(v4u*)((bf16*)(F.ws + WS_VR) + (size_t)idx * 512 + lane * 8) = (v4u){0u, 0u, 0u, 0u}; continue; }
        const v4u a = *(const v4u*)rowp, c = *(const v4u*)(rowp + 8);
        float x[16];
        x[0] = bflo(a.x); x[1] = bfhi(a.x); x[2] = bflo(a.y); x[3] = bfhi(a.y); x[4] = bflo(a.z); x[5] = bfhi(a.z); x[6] = bflo(a.w); x[7] = bfhi(a.w);
        x[8] = bflo(c.x); x[9] = bfhi(c.x); x[10] = bflo(c.y); x[11] = bfhi(c.y); x[12] = bflo(c.z); x[13] = bfhi(c.z); x[14] = bflo(c.w); x[15] = bfhi(c.w);
        float ss = 0.f;
#pragma unroll
        for (int i = 0; i < 16; ++i) ss += x[i] * x[i];
        ss = sum4(ss);
        const float rstd = 1.f / sqrtf(ss * (1.f / 64.f) + EPS);
#pragma unroll
        for (int i = 0; i < 16; ++i) x[i] = x[i] * rstd * gn[i];
        if (sub == 0) { const float pos = (float)(pp - 48);
#pragma unroll
            for (int i = 0; i < 8; ++i) { const float rev = __builtin_amdgcn_fractf(pos * invf[i] * 0.15915494309189535f);
                const float sn = __builtin_amdgcn_sinf(rev), cs = __builtin_amdgcn_cosf(rev); const float x1 = x[i], x2 = x[i + 8]; x[i] = x1 * cs - x2 * sn; x[i + 8] = x2 * cs + x1 * sn; } }
        v4u o0, o1;
        o0.x = pk2(x[0] * qscale, x[1] * qscale); o0.y = pk2(x[2] * qscale, x[3] * qscale); o0.z = pk2(x[4] * qscale, x[5] * qscale); o0.w = pk2(x[6] * qscale, x[7] * qscale);
        o1.x = pk2(x[8] * qscale, x[9] * qscale); o1.y = pk2(x[10] * qscale, x[11] * qscale); o1.z = pk2(x[12] * qscale, x[13] * qscale); o1.w = pk2(x[14] * qscale, x[15] * qscale);
        *(v4u*)rowp = o0; *(v4u*)(rowp + 8) = o1;
    }
}

__device__ __forceinline__ void v_transpose(Frame& F) {
    int tz_ = F.wave * 64 + LANE_ID(); asm volatile("" : "+v"(tz_)); const int tid = tz_, lane = tz_ & 63, wave = __builtin_amdgcn_readfirstlane(tz_ >> 6); (void)tid; (void)lane; (void)wave;

    const bf16* VR = (const bf16*)(F.ws + WS_VR); bf16* VT = (bf16*)(F.ws + WS_VT);
    constexpr int PITCH = 1040;
    for (int unit = F.vcu; unit < NB * NCH; unit += F.G) {
        const int b = unit / NCH, j = unit % NCH;
#pragma unroll
        for (int i = 0; i < 8; ++i) { const int id = tid + 512 * i, row = id >> 6, c8 = id & 63, pp = 64 * j + row;
            v4u v = *(const v4u*)(VR + (size_t)(b * LP + (pp < 48 ? 48 : pp)) * 512 + c8 * 8); if (pp < 48) v = (v4u){0u, 0u, 0u, 0u};
            *(LAS v4u*)(F.lds + row * PITCH + c8 * 16) = v; }
        __syncthreads();
        const int c = tid;
        unsigned w[32];
#pragma unroll
        for (int k = 0; k < 32; ++k) { const unsigned lo = *(const LAS unsigned short*)(F.lds + (2 * k) * PITCH + c * 2), hi = *(const LAS unsigned short*)(F.lds + (2 * k + 1) * PITCH + c * 2); w[k] = lo | (hi << 16); }
        bf16* dst = VT + ((size_t)(b * 4 + (c >> 7)) * 128 + (c & 127)) * LP + 64 * j;
#pragma unroll
        for (int k = 0; k < 8; ++k) *(v4u*)(dst + 8 * k) = (v4u){w[4 * k], w[4 * k + 1], w[4 * k + 2], w[4 * k + 3]};
        __syncthreads();
    }
}

__device__ __forceinline__ bf16x8 frag_nat(const LAS unsigned char* base, int rowbytes, int row, int quad, int ks) {
    return *(const LAS bf16x8*)(base + row * rowbytes + (32 * ks + 8 * quad) * 2);
}
__device__ __forceinline__ bf16x8 frag_pi(const LAS unsigned char* base, int rowbytes, int row, int quad, int ks) {
    const bf16x4 lo = *(const LAS bf16x4*)(base + row * rowbytes + (32 * ks + 4 * quad) * 2);
    const bf16x4 hi = *(const LAS bf16x4*)(base + row * rowbytes + (32 * ks + 16 + 4 * quad) * 2);
    return (bf16x8){lo[0], lo[1], lo[2], lo[3], hi[0], hi[1], hi[2], hi[3]};
}
__device__ __forceinline__ bf16x8 pack_tiles(const f32x4& a, const f32x4& b) {
    const v4u w = pack8(a, b); return __builtin_bit_cast(bf16x8, w);
}
__device__ __forceinline__ float row16_sum(float v) {
    v += __builtin_bit_cast(float, __builtin_amdgcn_update_dpp(0, __builtin_bit_cast(int, v), 0x128, 0xf, 0xf, true));
    v += __builtin_bit_cast(float, __builtin_amdgcn_update_dpp(0, __builtin_bit_cast(int, v), 0x124, 0xf, 0xf, true));
    v += __builtin_bit_cast(float, __builtin_amdgcn_update_dpp(0, __builtin_bit_cast(int, v), 0x122, 0xf, 0xf, true));
    v += __builtin_bit_cast(float, __builtin_amdgcn_update_dpp(0, __builtin_bit_cast(int, v), 0x121, 0xf, 0xf, true));
    return v;
}
#define SCHED_BAR() __builtin_amdgcn_sched_barrier(0)
#define MFMA16(a, b, c) __builtin_amdgcn_mfma_f32_16x16x32_bf16((a), (b), (c), 0, 0, 0)


template <class ZF, class OF, class VF>
__device__ __forceinline__ void post_tile(const int wv_, LAS unsigned char* L, const unsigned char* raw, const float* gain, ZF zrow, OF orow, VF ok,
                                          const bf16* cq = nullptr, const float* cdpre = nullptr, const bf16* csin = nullptr) {
    int tz_ = wv_ * 64 + LANE_ID(); asm volatile("" : "+v"(tz_)); const int tid = tz_;
    LAS float* T = (LAS float*)L;
    const int c_ = tid >> 3, e16_ = (tid & 7) * 16;
    const bf16* zp_ = zrow(c_) + e16_; const v4u z0 = *(const v4u*)zp_, z1 = *(const v4u*)(zp_ + 8);
    f32x4 gq[4];
#pragma unroll
    for (int k = 0; k < 4; ++k) gq[k] = *(const f32x4*)(gain + e16_ + 4 * k);
#pragma unroll
    for (int i = 0; i < 4; ++i) { const int gid = tid + 512 * i, wv = gid >> 8, rb = (gid >> 6) & 3, ln = gid & 63, q4 = ln >> 4, col = ln & 15;
        const v2u w = *(const v2u*)(raw + (size_t)gid * 8); LAS float* d = T + (16 * rb + 4 * q4) * 132 + 16 * wv + col;
        d[0] = bflo(w.x); d[132] = bfhi(w.x); d[264] = bflo(w.y); d[396] = bfhi(w.y); }
    if (cq) {
        LAS unsigned char* QT = L + 33792; LAS unsigned char* ST = L + 51200;
#pragma unroll
        for (int i = 0; i < 2; ++i) { const int id = tid + 512 * i, row = id >> 4, c16 = id & 15; const v4u q = *(const v4u*)(cq + (size_t)id * 8);
            const f32x4 d0 = *(const f32x4*)(cdpre + 8 * c16), d1 = *(const f32x4*)(cdpre + 8 * c16 + 4);
            *(LAS v4u*)(QT + row * 272 + c16 * 16) = (v4u){pk2(bflo(q.x) * d0[0], bfhi(q.x) * d0[1]), pk2(bflo(q.y) * d0[2], bfhi(q.y) * d0[3]), pk2(bflo(q.z) * d1[0], bfhi(q.z) * d1[1]), pk2(bflo(q.w) * d1[2], bfhi(q.w) * d1[3])}; }
        if (csin) {
#pragma unroll
            for (int i = 0; i < 4; ++i) { const int id = tid + 512 * i, row = id >> 4, c16 = id & 15; *(LAS v4u*)(ST + row * 272 + c16 * 16) = *(const v4u*)(csin + (size_t)id * 8); }
        }
        __syncthreads();
        const int lane = tid & 63, nb = __builtin_amdgcn_readfirstlane(tid >> 6), row = lane & 15, quad = lane >> 4;
        bf16x8 bs[4];
#pragma unroll
        for (int ks = 0; ks < 4; ++ks) bs[ks] = frag_nat(ST, 272, 16 * nb + row, quad, ks);
#pragma unroll
        for (int rb = 0; rb < 4; ++rb) { f32x4 acc = (f32x4){0.f, 0.f, 0.f, 0.f};
#pragma unroll
            for (int ks = 0; ks < 4; ++ks) acc = MFMA16(frag_nat(QT, 272, 16 * rb + row, quad, ks), bs[ks], acc);
            LAS float* d = T + (16 * rb + 4 * quad) * 132 + 16 * nb + row; d[0] += acc[0]; d[132] += acc[1]; d[264] += acc[2]; d[396] += acc[3]; }
    }
    __syncthreads();
    {   const int c = c_, e16 = e16_;
        float v[16]; float ss = 0.f;
#pragma unroll
        for (int k = 0; k < 4; ++k) { const f32x4 x = *(const LAS f32x4*)(T + c * 132 + e16 + 4 * k); v[4 * k] = x[0]; v[4 * k + 1] = x[1]; v[4 * k + 2] = x[2]; v[4 * k + 3] = x[3];
            ss += (x[0] * x[0] + x[1] * x[1]) + (x[2] * x[2] + x[3] * x[3]); }
        ss = sum8(ss);
        const float rstd = 1.f / sqrtf(ss * (1.f / 128.f) + EPS);
        const unsigned zw[8] = {z0.x, z0.y, z0.z, z0.w, z1.x, z1.y, z1.z, z1.w};
        unsigned ow[8];
#pragma unroll
        for (int k = 0; k < 8; ++k) { const float g0 = gq[k >> 1][(k & 1) * 2], g1 = gq[k >> 1][(k & 1) * 2 + 1];
            ow[k] = pk2(v[2 * k] * rstd * g0 * siluf_(bflo(zw[k])), v[2 * k + 1] * rstd * g1 * siluf_(bfhi(zw[k]))); }
        if (ok(c)) { bf16* op = orow(c) + e16; *(v4u*)op = (v4u){ow[0], ow[1], ow[2], ow[3]}; *(v4u*)(op + 8) = (v4u){ow[4], ow[5], ow[6], ow[7]}; }
    }
    __syncthreads();
}

constexpr int DP_QS = 0, DP_KS = 17408, DP_VT = 34816, DP_KGT = 53248, DP_KT = 71680, DP_MS = 90112, DP_TS = 107520, DP_GC = 116736, DP_BETA = 116992, DP_CW = 117248, DP_X = 133120, DP_P = 150528;
constexpr int DP_SQ = 90112, DP_SK = 133120, DP_SVA = 108336, DP_SVB = 151344, DP_SV_SPLIT = 30;
static_assert(DP_SVA + DP_SV_SPLIT * 272 <= 116736 && DP_SVB + (67 - DP_SV_SPLIT) * 272 <= LDS_BYTES && DP_SK + 67 * 272 <= DP_SVB && DP_P + 4352 <= LDS_BYTES, "dn_prep staging map");
__device__ __forceinline__ int dp_stage_off(int g, int srow) { return g == 0 ? DP_SQ + srow * 272 : g == 1 ? DP_SK + srow * 272 : (srow < DP_SV_SPLIT ? DP_SVA + srow * 272 : DP_SVB + (srow - DP_SV_SPLIT) * 272); }
#define DP_PF_LOAD(pf_, pc_, pbg_, b_, h_, n_) do { \
        { const int pp_ = 64 * (n_) + (tid & 63); const float* p_ = (const float*)(F.ws + WS_BG) + (size_t)((b_) * LP + (pp_ < 48 ? 48 : pp_)) * 8; pbg_[0] = p_[(h_)]; pbg_[1] = p_[4 + (h_)]; } \
        _Pragma("unroll") for (int k_ = 0; k_ < 3; ++k_) { const int idx_ = tid + 512 * k_, j_ = idx_ / 384, c_ = idx_ % 384; pc_[k_] = F.in[I_BCONV][j_ * 1536 + (c_ >> 7) * 512 + (h_) * 128 + (c_ & 127)]; } \
        _Pragma("unroll") for (int i_ = 0; i_ < 7; ++i_) { const int idx0_ = tid + 512 * i_, idx_ = idx0_ < 67 * 48 ? idx0_ : 67 * 48 - 1; const int srow_ = idx_ / 48, rem_ = idx_ % 48, g_ = rem_ >> 4, ch_ = rem_ & 15; const int ppj_ = 64 * (n_) - 3 + srow_; \
            pf_[i_] = *(const v4u*)((const bf16*)(F.ws + WS_CRAW) + (size_t)((b_) * LP + (ppj_ < 48 ? 48 : ppj_)) * 1536 + g_ * 512 + (h_) * 128 + ch_ * 8); } } while (0)
__device__ __forceinline__ void dn_prep_unit(Frame& F, int b, int h, int n, v4u (&pf)[7], float (&pc)[3], float (&pbg)[2], int nb, int nh, int nn) {
    LAS unsigned char* L = F.lds;
    int tz = F.wave * 64 + LANE_ID(); asm volatile("" : "+v"(tz));
    const int tid = tz, lane = tz & 63, wave = __builtin_amdgcn_readfirstlane(tz >> 6);
    const bf16* CR = (const bf16*)(F.ws + WS_CRAW); const float* BG = (const float*)(F.ws + WS_BG);
    unsigned char* blob = F.ws + WS_SCAN0 + (size_t)((b * 4 + h) * NCH + n) * DN_BLOB;
    LAS float* GCs = (LAS float*)(L + DP_GC); LAS float* BETAs = (LAS float*)(L + DP_BETA); LAS float* CW = (LAS float*)(L + DP_CW);
    if (tid < 64) { const int pp = 64 * n + tid; float be = pbg[0], g = pbg[1]; (void)BG;
        if (pp < 48) { be = 0.f; g = 0.f; }
#pragma unroll
        for (int o = 1; o < 64; o <<= 1) { const float t = __shfl_up(g, o); if (lane >= o) g += t; }
        GCs[tid] = g; BETAs[tid] = be; *(float*)(blob + DN_GC + tid * 4) = g; }
#pragma unroll
    for (int k = 0; k < 3; ++k) CW[tid + 512 * k] = pc[k];
#pragma unroll
    for (int i = 0; i < 7; ++i) { const int idx0 = tid + 512 * i, idx = idx0 < 67 * 48 ? idx0 : 67 * 48 - 1; { const int srow = idx / 48, rem = idx % 48, g = rem >> 4, ch = rem & 15; const int ppj = 64 * n - 3 + srow;
            v4u x = pf[i]; if (ppj < 48) x = (v4u){0u, 0u, 0u, 0u}; (void)CR;
            *(LAS v4u*)(L + dp_stage_off(g, srow) + ch * 16) = x; } }
    DP_PF_LOAD(pf, pc, pbg, nb, nh, nn);
    __syncthreads();
    {
        const int i = tid >> 3, part = tid & 7;
        const float be = BETAs[i], eg = fast_exp(GCs[i]);
#pragma unroll 1
        for (int g = 0; g < 3; ++g) {
            float a[16];
#pragma unroll
            for (int c = 0; c < 16; ++c) a[c] = 0.f;
#pragma unroll
            for (int j = 0; j < 4; ++j) { const LAS unsigned char* stg = L + dp_stage_off(g, i + j) + part * 32; const v4u x0 = *(const LAS v4u*)stg, x1 = *(const LAS v4u*)(stg + 16);
                const LAS float* w = CW + j * 384 + g * 128 + part * 16;
                a[0] += w[0] * bflo(x0.x); a[1] += w[1] * bfhi(x0.x); a[2] += w[2] * bflo(x0.y); a[3] += w[3] * bfhi(x0.y);
                a[4] += w[4] * bflo(x0.z); a[5] += w[5] * bfhi(x0.z); a[6] += w[6] * bflo(x0.w); a[7] += w[7] * bfhi(x0.w);
                a[8] += w[8] * bflo(x1.x); a[9] += w[9] * bfhi(x1.x); a[10] += w[10] * bflo(x1.y); a[11] += w[11] * bfhi(x1.y);
                a[12] += w[12] * bflo(x1.z); a[13] += w[13] * bfhi(x1.z); a[14] += w[14] * bflo(x1.w); a[15] += w[15] * bfhi(x1.w); }
            float ss = 0.f;
#pragma unroll
            for (int c = 0; c < 16; ++c) { a[c] = siluf_(a[c]); ss += a[c] * a[c]; }
            ss = sum8(ss);
            float sc = 1.f / sqrtf(ss + EPS);
            if (g == 0) sc *= 0.08838834764831845f; else if (g == 2) sc = be;
#pragma unroll
            for (int c = 0; c < 16; ++c) a[c] *= sc;
            if (g < 2) {
                const v4u p0 = (v4u){pk2(a[0], a[1]), pk2(a[2], a[3]), pk2(a[4], a[5]), pk2(a[6], a[7])}, p1 = (v4u){pk2(a[8], a[9]), pk2(a[10], a[11]), pk2(a[12], a[13]), pk2(a[14], a[15])};
                const int off = (g == 0) ? DP_QS : DP_KS;
                *(LAS v4u*)(L + off + i * 272 + part * 32) = p0; *(LAS v4u*)(L + off + i * 272 + part * 32 + 16) = p1;
                if (g == 0) { *(v4u*)(blob + DN_Q + (i * 128 + part * 16) * 2) = p0; *(v4u*)(blob + DN_Q + (i * 128 + part * 16) * 2 + 16) = p1; }
            }
            if (g == 1) {
#pragma unroll
                for (int c = 0; c < 16; ++c) { const int ch = part * 16 + c;
                    *(LAS bf16*)(L + DP_KT + ch * 144 + i * 2) = f2bf(a[c]);
                    *(LAS bf16*)(L + DP_KGT + ch * 144 + i * 2) = f2bf(be * a[c] * eg); }
            }
            if (g == 2) {
#pragma unroll
                for (int c = 0; c < 16; ++c) *(LAS bf16*)(L + DP_VT + (part * 16 + c) * 144 + i * 2) = f2bf(a[c]);
            }
        }
    }
    __syncthreads();
    {
        const int row = lane & 15, quad = lane >> 4, ib = wave & 3; const bool isqk = wave >= 4;
        const LAS unsigned char* Abase = L + (isqk ? DP_QS : DP_KS);
        bf16x8 af[4];
#pragma unroll
        for (int ks = 0; ks < 4; ++ks) af[ks] = frag_nat(Abase, 272, 16 * ib + row, quad, ks);
        LAS float* MS = (LAS float*)(L + DP_MS);
#pragma unroll
        for (int jb = 0; jb < 4; ++jb) {
            f32x4 acc = (f32x4){0.f, 0.f, 0.f, 0.f};
            if (jb <= ib) {
#pragma unroll
                for (int ks = 0; ks < 4; ++ks) acc = MFMA16(af[ks], frag_nat(L + DP_KS, 272, 16 * jb + row, quad, ks), acc);
            }
            const int j = 16 * jb + row; const float gj = GCs[j];
#pragma unroll
            for (int r = 0; r < 4; ++r) { const int i = 16 * ib + 4 * quad + r; const float dec = fast_exp(GCs[i] - gj);
                if (isqk) { const float v = (j <= i) ? acc[r] * dec : 0.f; *(bf16*)(blob + DN_QK + (i * 64 + j) * 2) = f2bf(v); }
                else { const float v = (j < i) ? BETAs[i] * acc[r] * dec : 0.f; MS[i * 68 + j] = v; } }
        }
    }
    __syncthreads();
    {
        int zo = 0; asm volatile("" : "+v"(zo));
        const LAS float* MS = (const LAS float*)(L + DP_MS) + zo; LAS float* X = (LAS float*)(L + DP_X) + zo; LAS float* P = (LAS float*)(L + DP_P) + zo;
        if (wave < 4) {
            const int c = lane & 15, o = 16 * wave; float t[16];
#pragma unroll
            for (int i = 0; i < 16; ++i) { float acc = (c == i) ? 1.f : 0.f;
#pragma unroll
                for (int j4 = 0; j4 < (i + 3) / 4; ++j4) { const f32x4 mv = *(const LAS f32x4*)(MS + (o + i) * 68 + o + 4 * j4);
#pragma unroll
                    for (int q = 0; q < 4; ++q) if (4 * j4 + q < i) acc -= mv[q] * t[4 * j4 + q]; }
                t[i] = acc; }
            if (lane < 16) {
#pragma unroll
                for (int i = 0; i < 16; ++i) X[(o + i) * 68 + o + c] = t[i]; }
        } else {
            const int w2 = wave - 4, blk = w2 >> 1, hl = w2 & 1;
#pragma unroll
            for (int q = 0; q < 2; ++q) { const int id = hl * 128 + q * 64 + lane, r = id >> 4, cc = id & 15; X[(32 * blk + r) * 68 + 32 * blk + 16 + cc] = 0.f; }
        }
        __syncthreads();
        {
            const int blk = tid >> 8, r = (tid >> 4) & 15, c = tid & 15, R0 = 32 * blk + 16, C0 = 32 * blk;
            float acc = 0.f;
#pragma unroll
            for (int k = 0; k < 16; ++k) acc += MS[(R0 + r) * 68 + C0 + k] * X[(C0 + k) * 68 + C0 + c];
            P[blk * 272 + r * 17 + c] = acc;
            __syncthreads();
            float o2 = 0.f;
#pragma unroll
            for (int k = 0; k < 16; ++k) o2 -= X[(R0 + r) * 68 + R0 + k] * P[blk * 272 + k * 17 + c];
            X[(R0 + r) * 68 + C0 + c] = o2;
        }
        __syncthreads();
        {
            const int r = tid >> 4, c0 = (tid & 15) * 2;
            float a0 = 0.f, a1 = 0.f;
#pragma unroll
            for (int k = 0; k < 32; ++k) { const float m = MS[(32 + r) * 68 + k]; a0 += m * X[k * 68 + c0]; a1 += m * X[k * 68 + c0 + 1]; }
            P[r * 34 + c0] = a0; P[r * 34 + c0 + 1] = a1;
            __syncthreads();
            float o0 = 0.f, o1 = 0.f;
#pragma unroll
            for (int k = 0; k < 32; ++k) { const float x = X[(32 + r) * 68 + 32 + k]; o0 -= x * P[k * 34 + c0]; o1 -= x * P[k * 34 + c0 + 1]; }
            X[(32 + r) * 68 + c0] = o0; X[(32 + r) * 68 + c0 + 1] = o1;
        }
        __syncthreads();
        {
            const int i = tid >> 3, c8 = (tid & 7) * 8; float v[8];
#pragma unroll
            for (int q = 0; q < 8; ++q) v[q] = ((c8 >> 4) > (i >> 4)) ? 0.f : X[i * 68 + c8 + q];
            *(LAS v4u*)(L + DP_TS + i * 144 + c8 * 2) = (v4u){pk2(v[0], v[1]), pk2(v[2], v[3]), pk2(v[4], v[5]), pk2(v[6], v[7])};
        }
    }
    __syncthreads();
    {
        const int row = lane & 15, quad = lane >> 4, nb = wave;
        bf16x8 bv[2], bk[2];
#pragma unroll
        for (int ks = 0; ks < 2; ++ks) { bv[ks] = frag_nat(L + DP_VT, 144, 16 * nb + row, quad, ks); bk[ks] = frag_nat(L + DP_KGT, 144, 16 * nb + row, quad, ks); }
#pragma unroll
        for (int rb = 0; rb < 4; ++rb) {
            f32x4 au = (f32x4){0.f, 0.f, 0.f, 0.f}, aw = (f32x4){0.f, 0.f, 0.f, 0.f};
#pragma unroll
            for (int ks = 0; ks < 2; ++ks) { const bf16x8 a = frag_nat(L + DP_TS, 144, 16 * rb + row, quad, ks); au = MFMA16(a, bv[ks], au); aw = MFMA16(a, bk[ks], aw); }
            *(v2u*)(blob + DN_U + (size_t)(((nb * 4 + rb) * 64 + lane) * 4) * 2) = (v2u){pk2(au[0], au[1]), pk2(au[2], au[3])};
#pragma unroll
            for (int r = 0; r < 4; ++r) *(bf16*)(blob + DN_W + ((16 * rb + 4 * quad + r) * 128 + 16 * nb + row) * 2) = f2bf(aw[r]);
        }
#pragma unroll
        for (int i = 0; i < 2; ++i) { const int id = tid + 512 * i, rr = id >> 3, c = id & 7; *(v4u*)(blob + DN_KT + (rr * 64 + c * 8) * 2) = *(const LAS v4u*)(L + DP_KT + rr * 144 + c * 16); }
    }
    __syncthreads();
}
__device__ __forceinline__ void phase_prep0(Frame& F, bool with_qk) {
    int tz = F.wave * 64 + LANE_ID(); asm volatile("" : "+v"(tz)); const int tid = tz;
    v4u pf[7]; float pc[3], pbg[2];
    { const int u0 = F.vcu < NB * 4 * NCH ? F.vcu : 0; const int bh0 = u0 / NCH, n0 = u0 % NCH; DP_PF_LOAD(pf, pc, pbg, bh0 >> 2, bh0 & 3, n0); }
    for (int unit = F.vcu; unit < NB * 4 * NCH; unit += F.G) { const int bh = unit / NCH, n = unit % NCH;
        const int un = (unit + F.G < NB * 4 * NCH) ? unit + F.G : unit; const int bhn = un / NCH, nn = un % NCH;
        dn_prep_unit(F, bh >> 2, bh & 3, n, pf, pc, pbg, bhn >> 2, bhn & 3, nn); }
    if (with_qk) qk_prep(F);
}

__device__ __forceinline__ float swap32_max(float v) { auto rr = __builtin_amdgcn_permlane32_swap(__float_as_uint(v), __float_as_uint(v), false, false); return fmaxf(__uint_as_float(rr[0]), __uint_as_float(rr[1])); }
__device__ __forceinline__ float swap32_sum(float v) { auto rr = __builtin_amdgcn_permlane32_swap(__float_as_uint(v), __float_as_uint(v), false, false); return __uint_as_float(rr[0]) + __uint_as_float(rr[1]); }
#define MFMA32(a, b, c) __builtin_amdgcn_mfma_f32_32x32x16_bf16((a), (b), (c), 0, 0, 0)

__device__ __forceinline__ void glds16(const void* gsrc, unsigned lds_dst) { unsigned keep;
    asm volatile("s_mov_b32 %0, m0\n\ts_mov_b32 m0, %2\n\ts_nop 0\n\tglobal_load_lds_dwordx4 %1, off\n\ts_mov_b32 m0, %0" : "=&s"(keep) : "v"(gsrc), "s"(lds_dst) : "memory"); }
__device__ __forceinline__ void glds16s(const void* sbase, unsigned voff, unsigned lds_dst) { unsigned keep;
    asm volatile("s_mov_b32 %0, m0\n\ts_mov_b32 m0, %3\n\ts_nop 0\n\tglobal_load_lds_dwordx4 %1, %2\n\ts_mov_b32 m0, %0" : "=&s"(keep) : "v"(voff), "s"(sbase), "s"(lds_dst) : "memory"); }
constexpr float AT_THR = 6.f;
constexpr int AT_K0 = 0, AT_K1 = 8192, AT_VT = 16384, AT_STAGE = 32768, AT_NST = 4;
__device__ __forceinline__ void attn_unit(Frame& F, int b, int h, int cb) {
    LAS unsigned char* L = F.lds;
    int tz = F.wave * 64 + LANE_ID(); asm volatile("" : "+v"(tz));
    const int tid = tz, lane = tz & 63, wave = __builtin_amdgcn_readfirstlane(tz >> 6);
    const int comp = wave >> 2, wq = wave & 3, m = lane & 31, hh = lane >> 5;
    const bf16* Qb = (const bf16*)(F.ws + WS_Q); const bf16* Kb = (const bf16*)(F.ws + WS_K); const bf16* VRb = (const bf16*)(F.ws + WS_VR); bf16* Ob = (bf16*)(F.ws + WS_O);
    const int pq = 64 * cb + 32 * wq + m; const bool valid = pq >= 48; const int pc = pq < 48 ? 48 : pq;
    bf16x8 qf[4];
    { const bf16* qsrc = Qb + (size_t)(b * LP + pc) * 512 + (2 * h + comp) * 64 + 8 * hh;
#pragma unroll
      for (int d0 = 0; d0 < 4; ++d0) qf[d0] = *(const bf16x8*)(qsrc + 16 * d0);
      asm volatile("" : "+v"(qf[0]), "+v"(qf[1]), "+v"(qf[2]), "+v"(qf[3])); }
    const int chunk_w = cb + (wq >> 1); const int ntw = chunk_w + 1, nt = cb + 2;
    const int prow = lane >> 3, ppos = lane & 7;
    const int krow = 8 * wave + prow, kch = ppos ^ ((krow >> 1) & 7);
    const unsigned kvo = (unsigned)(krow * 1024 + kch * 16);
    const int vrow0 = 8 * (wave >> 1) + ((lane >> 2) & 7), vch0 = 4 * (2 * (wave & 1) + (lane >> 5)) + ((lane & 3) ^ ((vrow0 >> 2) & 3));
    const unsigned vvo = (unsigned)(vrow0 * 1024 + vch0 * 16);
    const int bu = __builtin_amdgcn_readfirstlane(b), hu = __builtin_amdgcn_readfirstlane(h);
    const bf16* kgu = Kb + (size_t)(bu * LP) * 512 + (2 * hu) * 64;
    const bf16* vgu = VRb + (size_t)(bu * LP) * 512 + hu * 128;
    const unsigned pbase = (unsigned)wave * 1024u;
    const unsigned lds0 = (unsigned)(size_t)L;
#define AT_DMA_K(tt, st) do { const unsigned S_ = (unsigned)__builtin_amdgcn_readfirstlane((int)(lds0 + (st) * AT_STAGE + pbase)); \
        glds16s(kgu + (size_t)(tt) * 64 * 512, kvo, S_ + AT_K0); glds16s(kgu + (size_t)(tt) * 64 * 512 + 64, kvo, S_ + AT_K1); } while (0)
#define AT_DMA_V(tt, st) do { const unsigned S_ = (unsigned)__builtin_amdgcn_readfirstlane((int)(lds0 + (st) * AT_STAGE + pbase)); \
        glds16s(vgu + (size_t)(tt) * 64 * 512, vvo, S_ + AT_VT); glds16s(vgu + (size_t)(tt) * 64 * 512 + (size_t)32 * 512, vvo, S_ + AT_VT + 8192); } while (0)
    const int sig = (m & ~12) | ((m & 4) << 1) | ((m & 8) >> 1);
    const int kbase = comp * AT_K1 + sig * 128 + hh * 16, kkey = ((sig >> 1) & 7) * 16;
    AT_DMA_K(0, 0); AT_DMA_V(0, 0); if (1 < nt) { AT_DMA_K(1, 1); AT_DMA_V(1, 1); } if (2 < nt) AT_DMA_K(2, 2);
    if (2 < nt) asm volatile("s_waitcnt vmcnt(8)" ::: "memory"); else if (1 < nt) asm volatile("s_waitcnt vmcnt(6)" ::: "memory"); else asm volatile("s_waitcnt vmcnt(2)" ::: "memory");
    __builtin_amdgcn_s_barrier();
    f32x16 o[4];
#pragma unroll
    for (int d = 0; d < 4; ++d)
#pragma unroll
        for (int i = 0; i < 16; ++i) o[d][i] = 0.f;
    float mrun = 0.f, lrun = 0.f, alpha = 1.f; bool resc = false;
    f32x16 pA0, pA1, pB0, pB1;
    f32x16 negm;
#pragma unroll
    for (int i = 0; i < 16; ++i) { negm[i] = 0.f; pA0[i] = 0.f; pA1[i] = 0.f; pB0[i] = 0.f; pB1[i] = 0.f; }
    int kx[4];
#pragma unroll
    for (int j = 0; j < 4; ++j) kx[j] = (kbase + j * 32) ^ kkey;
    int vb0, vb1;
    { const int g = lane >> 4, gb = g & 1, q = (lane >> 2) & 3, p = lane & 3, cl = 2 * gb + (p >> 1);
      vb0 = AT_VT + 2048 * hh + 64 * q + 16 * (cl ^ ((2 * hh) & 3)) + 8 * (p & 1);
      vb1 = AT_VT + 2048 * hh + 64 * q + 16 * (cl ^ ((2 * hh + 1) & 3)) + 8 * (p & 1) + 256; }
    bf16x8 kf0 = qf[0], kf1 = qf[0], vf0 = qf[0], vf1 = qf[0], vf2 = qf[0];
#define AT_PIN(x) asm volatile("" : "+v"(x))
#define AT_KF(i) (*(const LAS bf16x8*)(Ls + kx[(i) >> 1] + ((i) & 1) * (32 * 128)))
#define AT_TR(p_) __builtin_amdgcn_ds_read_tr16_b64_v4i16((LAS s16x4_t*)(p_))
#define AT_VF(i) ({ const s16x4_t a_ = AT_TR(Lv + vb0 + 4096 * ((i) & 3) + 512 * ((i) >> 2)), b_ = AT_TR(Lv + vb1 + 4096 * ((i) & 3) + 512 * ((i) >> 2)); (bf16x8){a_[0], a_[1], a_[2], a_[3], b_[0], b_[1], b_[2], b_[3]}; })
#define AT_YV(Y0, Y1, j) ((j) < 16 ? Y0[(j) & 15] : Y1[(j) & 15])
#define AT_PB(Y0, s) __builtin_bit_cast(bf16x8, (f32x4){Y0[4 * (s)], Y0[4 * (s) + 1], Y0[4 * (s) + 2], Y0[4 * (s) + 3]})
#define AT_ISSUE(tt) do { if ((tt) + 3 < nt) AT_DMA_K((tt) + 3, ((tt) + 3) % AT_NST); if ((tt) + 2 < nt) AT_DMA_V((tt) + 2, ((tt) + 2) % AT_NST); } while (0)
#define AT_CLOSE(tt) do { const int rem_ = nt - (tt); \
        if (rem_ > 3) asm volatile("s_waitcnt vmcnt(8) lgkmcnt(0)" ::: "memory"); else if (rem_ == 3) asm volatile("s_waitcnt vmcnt(6) lgkmcnt(0)" ::: "memory"); \
        else if (rem_ == 2) asm volatile("s_waitcnt vmcnt(2) lgkmcnt(0)" ::: "memory"); else asm volatile("s_waitcnt vmcnt(0) lgkmcnt(0)" ::: "memory"); \
        __builtin_amdgcn_s_barrier(); } while (0)
#define AT_ROWMAX(X0, X1, mx) do { float a_ = fmaxf(fmaxf(X0[0], X0[1]), X1[0]), b_ = fmaxf(fmaxf(X0[2], X0[3]), X1[1]); a_ = fmaxf(fmaxf(a_, X1[2]), X1[3]); \
        _Pragma("unroll") for (int r = 4; r < 16; r += 4) { a_ = fmaxf(fmaxf(a_, X0[r]), X0[r + 1]); b_ = fmaxf(fmaxf(b_, X0[r + 2]), X0[r + 3]); a_ = fmaxf(fmaxf(a_, X1[r]), X1[r + 1]); b_ = fmaxf(fmaxf(b_, X1[r + 2]), X1[r + 3]); } \
        mx = swap32_max(fmaxf(a_, b_)); } while (0)
#define AT_SUMPACK(Y0, Y1) do { float sacc = 0.f; \
        _Pragma("unroll") for (int w = 0; w < 16; ++w) { sacc += AT_YV(Y0, Y1, 2 * w); sacc += AT_YV(Y0, Y1, 2 * w + 1); \
            const unsigned v_ = pk2(AT_YV(Y0, Y1, 2 * w), AT_YV(Y0, Y1, 2 * w + 1)); Y0[w] = __uint_as_float(v_); AT_PIN(Y0); AT_PIN(sacc); } \
        lrun += sacc; } while (0)
#define AT_PV(Y0, tt) do { const LAS unsigned char* Lv = L + (((tt) + AT_NST) % AT_NST) * AT_STAGE; \
        vf0 = AT_VF(0); vf1 = AT_VF(1); vf2 = AT_VF(2); \
        _Pragma("unroll") for (int i = 0; i < 16; ++i) { const bf16x8 c_ = vf0; vf0 = vf1; vf1 = vf2; if (i + 3 < 16) vf2 = AT_VF(i + 3); \
            o[i >> 2] = MFMA32(c_, AT_PB(Y0, i & 3), o[i >> 2]); SCHED_BAR(); } } while (0)
#define AT_XV(X0, X1, j) ((j) < 16 ? X0[(j) & 15] : X1[(j) & 15])
#define AT_EXP1(X0, X1, j) do { if ((j) < 16) X0[(j) & 15] = __builtin_amdgcn_exp2f(X0[(j) & 15]); else X1[(j) & 15] = __builtin_amdgcn_exp2f(X1[(j) & 15]); } while (0)
#define AT_STEP(X0, X1, Y0, Y1, tt) do { \
        const LAS unsigned char* Ls = L + ((tt) % AT_NST) * AT_STAGE; const LAS unsigned char* Lv = L + (((tt) + AT_NST - 1) % AT_NST) * AT_STAGE; \
        kf0 = AT_KF(0); kf1 = AT_KF(1); \
        const bool dk_ = (tt) + 3 < nt, dv_ = (tt) + 2 < nt; \
        const unsigned SK_ = (unsigned)__builtin_amdgcn_readfirstlane((int)(lds0 + (((tt) + 3) % AT_NST) * AT_STAGE + pbase)), SV_ = (unsigned)__builtin_amdgcn_readfirstlane((int)(lds0 + (((tt) + 2) % AT_NST) * AT_STAGE + pbase)); \
        float sacc = 0.f; SCHED_BAR(); \
        _Pragma("unroll") for (int i = 0; i < 8; ++i) { \
            const bf16x8 c_ = kf0; kf0 = kf1; if (i + 2 < 8) kf1 = AT_KF(i + 2); \
            if (i == 5) vf0 = AT_VF(0); if (i == 6) vf1 = AT_VF(1); if (i == 7) vf2 = AT_VF(2); \
            if (i == 0) X0 = MFMA32(c_, qf[0], negm); else if (i == 1) X1 = MFMA32(c_, qf[0], negm); else if (i & 1) X1 = MFMA32(c_, qf[i >> 1], X1); else X0 = MFMA32(c_, qf[i >> 1], X0); \
            sacc += AT_YV(Y0, Y1, 4 * i); sacc += AT_YV(Y0, Y1, 4 * i + 1); sacc += AT_YV(Y0, Y1, 4 * i + 2); sacc += AT_YV(Y0, Y1, 4 * i + 3); \
            { const unsigned v0_ = pk2(AT_YV(Y0, Y1, 4 * i), AT_YV(Y0, Y1, 4 * i + 1)), v1_ = pk2(AT_YV(Y0, Y1, 4 * i + 2), AT_YV(Y0, Y1, 4 * i + 3)); Y0[2 * i] = __uint_as_float(v0_); Y0[2 * i + 1] = __uint_as_float(v1_); } \
            AT_PIN(Y0); AT_PIN(sacc); SCHED_BAR(); } \
        lrun += sacc; resc = false; \
        float ma_ = -INFINITY, mb_ = -INFINITY; \
        _Pragma("unroll") for (int i = 0; i < 16; ++i) { const bf16x8 c_ = vf0; vf0 = vf1; vf1 = vf2; if (i + 3 < 16) vf2 = AT_VF(i + 3); \
            o[i >> 2] = MFMA32(c_, AT_PB(Y0, i & 3), o[i >> 2]); \
            if (i < 4) {   \
                ma_ = fmaxf(fmaxf(ma_, X0[4 * i]), X0[4 * i + 1]); mb_ = fmaxf(fmaxf(mb_, X0[4 * i + 2]), X0[4 * i + 3]); ma_ = fmaxf(fmaxf(ma_, X1[4 * i]), X1[4 * i + 1]); mb_ = fmaxf(fmaxf(mb_, X1[4 * i + 2]), X1[4 * i + 3]); \
                AT_PIN(ma_); AT_PIN(mb_); \
                if (i == 0 && dk_) glds16s(kgu + (size_t)((tt) + 3) * 64 * 512, kvo, SK_ + AT_K0); if (i == 1 && dk_) glds16s(kgu + (size_t)((tt) + 3) * 64 * 512 + 64, kvo, SK_ + AT_K1); \
                if (i == 2 && dv_) glds16s(vgu + (size_t)((tt) + 2) * 64 * 512, vvo, SV_ + AT_VT); if (i == 3 && dv_) glds16s(vgu + (size_t)((tt) + 2) * 64 * 512 + (size_t)32 * 512, vvo, SV_ + AT_VT + 8192); \
                if (i == 3) { const float mx = swap32_max(fmaxf(ma_, mb_)); \
                    if (__builtin_expect(__builtin_amdgcn_ballot_w64(mx > AT_THR) != 0ull, 0)) { const float dl = fmaxf(mx, 0.f); mrun += dl; alpha = __builtin_amdgcn_exp2f(-dl); lrun *= alpha; \
                        _Pragma("unroll") for (int r = 0; r < 16; ++r) { X0[r] -= dl; X1[r] -= dl; negm[r] = -mrun; } resc = true; } } \
            } else { const int k_ = i - 4, lo_ = (k_ * 8) / 3, hi_ = ((k_ + 1) * 8) / 3; \
                AT_EXP1(X0, X1, lo_); AT_EXP1(X0, X1, lo_ + 1); if (hi_ - lo_ == 3) AT_EXP1(X0, X1, lo_ + 2); \
                if (lo_ < 16) AT_PIN(X0); if (hi_ > 16) AT_PIN(X1); } \
            SCHED_BAR(); } \
        if (resc) { _Pragma("unroll") for (int d = 0; d < 4; ++d) _Pragma("unroll") for (int i = 0; i < 16; ++i) o[d][i] *= alpha; } \
    } while (0)
    if (ntw >= 1) {
        const LAS unsigned char* Ls = L;
        AT_ISSUE(0);
#pragma unroll
        for (int i = 0; i < 8; ++i) { const bf16x8 c_ = AT_KF(i);
            if (i == 0) pA0 = MFMA32(c_, qf[0], negm); else if (i == 1) pA1 = MFMA32(c_, qf[0], negm); else if (i & 1) pA1 = MFMA32(c_, qf[i >> 1], pA1); else pA0 = MFMA32(c_, qf[i >> 1], pA0); }
#pragma unroll
        for (int i = 0; i < 16; ++i) pA0[i] = -INFINITY;
#pragma unroll
        for (int i = 0; i < 8; ++i) pA1[i] = -INFINITY;
        float mx = fmaxf(fmaxf(pA1[8], pA1[9]), fmaxf(pA1[10], pA1[11])); mx = fmaxf(mx, fmaxf(fmaxf(pA1[12], pA1[13]), fmaxf(pA1[14], pA1[15]))); mx = swap32_max(mx);
        mrun = mx;
#pragma unroll
        for (int i = 0; i < 16; ++i) { negm[i] = -mx; pA0[i] = 0.f; pA1[i] = (i < 8) ? 0.f : __builtin_amdgcn_exp2f(pA1[i] - mx); }
    } else AT_ISSUE(0);
    AT_CLOSE(0);
    {
        int t = 1;
        for (; t + 1 < ntw; t += 2) {
            AT_STEP(pB0, pB1, pA0, pA1, t); AT_CLOSE(t);
            AT_STEP(pA0, pA1, pB0, pB1, t + 1); AT_CLOSE(t + 1);
        }
        if (ntw >= 1) {
            if (t < ntw) { AT_STEP(pB0, pB1, pA0, pA1, t); AT_CLOSE(t); ++t; AT_ISSUE(t); AT_SUMPACK(pB0, pB1); AT_PV(pB0, t - 1); }
            else { AT_ISSUE(t); AT_SUMPACK(pA0, pA1); AT_PV(pA0, t - 1); }
            AT_CLOSE(t); ++t;
        }
        for (; t <= nt; ++t) { AT_ISSUE(t); AT_CLOSE(t); }
    }
#undef AT_PIN
#undef AT_KF
#undef AT_VF
#undef AT_TR
#undef AT_YV
#undef AT_PB
#undef AT_ISSUE
#undef AT_CLOSE
#undef AT_ROWMAX
#undef AT_SUMPACK
#undef AT_PV
#undef AT_STEP
#undef AT_XV
#undef AT_EXP1
#undef AT_DMA_K
#undef AT_DMA_V
    const float l = swap32_sum(lrun);
    LAS float* X = (LAS float*)L;
    if (comp == 1) { const float sc = __uint_as_float(F.MISC[5]) * __builtin_amdgcn_rcpf(l);
#pragma unroll
        for (int d = 0; d < 4; ++d)
#pragma unroll
            for (int i = 0; i < 16; ++i) X[wq * 4096 + (32 * d + (i & 3) + 8 * (i >> 2) + 4 * hh) * 32 + m] = o[d][i] * sc; }
    __syncthreads();
    if (comp == 0) { const float inv = __builtin_amdgcn_rcpf(l); float ss = 0.f;
#pragma unroll
        for (int d = 0; d < 4; ++d)
#pragma unroll
            for (int i = 0; i < 16; ++i) { const float v = o[d][i] * inv - X[wq * 4096 + (32 * d + (i & 3) + 8 * (i >> 2) + 4 * hh) * 32 + m]; o[d][i] = v; ss += v * v; }
        ss = swap32_sum(ss);
        const float rstd = __builtin_amdgcn_rsqf(ss * (1.f / 128.f) + EPS) * 0.8f;
        if (valid) { bf16* orow = Ob + (size_t)r_of_bp(b, pq) * D + h * 128; const float* sg = F.in[I_ASUB];
#pragma unroll
            for (int d = 0; d < 4; ++d)
#pragma unroll
                for (int g = 0; g < 4; ++g) { const int dd = 32 * d + 8 * g + 4 * hh; const f32x4 gn = *(const f32x4*)(sg + dd);
                    *(v2u*)(orow + dd) = (v2u){pk2(o[d][4 * g] * rstd * gn[0], o[d][4 * g + 1] * rstd * gn[1]), pk2(o[d][4 * g + 2] * rstd * gn[2], o[d][4 * g + 3] * rstd * gn[3])}; } }
    }
    __syncthreads();
}

#ifndef DN_NSL
#define DN_NSL 2
#endif
constexpr int DN_WGS = 64 / DN_NSL;
constexpr int DS_W = 0, DS_Q = 17408, DS_KT = 34816, DS_QK = 53248, DS_STAGE = 62464, DS_GC = 124928;
constexpr int DS_ST = PRIV_OFF, DS_VN = PRIV_OFF + DN_NSL * 4352, DS_VS = DS_VN + DN_NSL * 2304;
constexpr int DS_UB = PRIV_OFF + 18432;
static_assert(DS_VS + DN_NSL * 2304 <= PRIV_OFF + 18432 && DS_UB + 2 * DN_NSL * 2048 <= LDS_BYTES, "scan LDS map");
constexpr int CW_DNDONE = 2048;
__device__ __forceinline__ void dn_scan(Frame& F, int unit) {
    LAS unsigned char* L = F.lds;
    const int bh = unit / (8 / DN_NSL), cg = unit % (8 / DN_NSL);
    int tz = F.wave * 64 + LANE_ID(); asm volatile("" : "+v"(tz));
    const int tid = tz, lane = tz & 63, wv = __builtin_amdgcn_readfirstlane(tz >> 6), col = lane & 15, q4 = lane >> 4;
    const bool roleA = wv < 4; const int rb = wv & 3;
    const unsigned char* blob0 = F.ws + WS_SCAN0 + (size_t)(bh * NCH) * DN_BLOB;
    f32x4 S[DN_NSL];
#pragma unroll
    for (int sl = 0; sl < DN_NSL; ++sl) S[sl] = (f32x4){0.f, 0.f, 0.f, 0.f};
    v4u pr[7]; float pgc = 0.f; v2u pu = (v2u){0u, 0u};
    const int id0 = tid, id1 = tid + 512;
#define DS_LOAD(n) do { const unsigned char* bl_ = blob0 + (size_t)(n) * DN_BLOB; \
        pr[0] = *(const v4u*)(bl_ + DN_W + id0 * 16); pr[1] = *(const v4u*)(bl_ + DN_W + id1 * 16); pr[2] = *(const v4u*)(bl_ + DN_Q + id0 * 16); pr[3] = *(const v4u*)(bl_ + DN_Q + id1 * 16); \
        pr[4] = *(const v4u*)(bl_ + DN_KT + id0 * 16); pr[5] = *(const v4u*)(bl_ + DN_KT + id1 * 16); pr[6] = *(const v4u*)(bl_ + DN_QK + id0 * 16); \
        if (tid < 64) pgc = *(const float*)(bl_ + DN_GC + tid * 4); \
        if (tid < 256 * DN_NSL) pu = *(const v2u*)(bl_ + DN_U + (size_t)((cg * DN_NSL * 256 + tid) * 4) * 2); } while (0)
#define DS_WRITE(s) do { LAS unsigned char* Ls_ = L + (s) * DS_STAGE; \
        *(LAS v4u*)(Ls_ + DS_W + (id0 >> 4) * 272 + (id0 & 15) * 16) = pr[0]; *(LAS v4u*)(Ls_ + DS_W + (id1 >> 4) * 272 + (id1 & 15) * 16) = pr[1]; \
        *(LAS v4u*)(Ls_ + DS_Q + (id0 >> 4) * 272 + (id0 & 15) * 16) = pr[2]; *(LAS v4u*)(Ls_ + DS_Q + (id1 >> 4) * 272 + (id1 & 15) * 16) = pr[3]; \
        *(LAS v4u*)(Ls_ + DS_KT + (id0 >> 3) * 144 + (id0 & 7) * 16) = pr[4]; *(LAS v4u*)(Ls_ + DS_KT + (id1 >> 3) * 144 + (id1 & 7) * 16) = pr[5]; \
        *(LAS v4u*)(Ls_ + DS_QK + (id0 >> 3) * 144 + (id0 & 7) * 16) = pr[6]; \
        if (tid < 64) *(LAS float*)(L + DS_GC + (s) * 256 + tid * 4) = pgc; \
        if (tid < 256 * DN_NSL) *(LAS v2u*)(L + DS_UB + (s) * (DN_NSL * 2048) + tid * 8) = pu; } while (0)
    DS_LOAD(0); DS_WRITE(0);
#pragma unroll
    for (int sl = 0; sl < DN_NSL; ++sl) *(LAS v2u*)(L + DS_ST + sl * 4352 + col * 272 + (16 * wv + 4 * q4) * 2) = (v2u){0u, 0u};
    __syncthreads();
    for (int n = 0; n < NCH; ++n) {
        const int cur = n & 1;
        const LAS unsigned char* Ls = L + cur * DS_STAGE; const LAS float* GC = (const LAS float*)(L + DS_GC + cur * 256);
        if (n + 1 < NCH) DS_LOAD(n + 1);
        const float gl = GC[63];
        const f32x4 gc4 = *(const LAS f32x4*)(GC + 16 * rb + 4 * q4);
        f32x4 ov[DN_NSL];
        {   bf16x8 fa[4];
            const LAS unsigned char* Ab = Ls + (roleA ? DS_W : DS_Q);
#pragma unroll
            for (int ks = 0; ks < 4; ++ks) fa[ks] = frag_nat(Ab, 272, 16 * rb + col, q4, ks);
#pragma unroll
            for (int sl = 0; sl < DN_NSL; ++sl) {
                bf16x8 fb[4];
#pragma unroll
                for (int ks = 0; ks < 4; ++ks) fb[ks] = frag_nat(L + DS_ST + sl * 4352, 272, col, q4, ks);
                f32x4 acc = (f32x4){0.f, 0.f, 0.f, 0.f};
#pragma unroll
                for (int ks = 0; ks < 4; ++ks) acc = MFMA16(fa[ks], fb[ks], acc);
                ov[sl] = (f32x4){0.f, 0.f, 0.f, 0.f};
                if (roleA) {
                    const v2u uw = *(const LAS v2u*)(L + DS_UB + cur * (DN_NSL * 2048) + (sl * 256 + rb * 64 + lane) * 8);
                    const f32x4 u = (f32x4){bflo(uw.x), bfhi(uw.x), bflo(uw.y), bfhi(uw.y)};
                    f32x4 vn, vs;
#pragma unroll
                    for (int r = 0; r < 4; ++r) { vn[r] = u[r] - acc[r]; vs[r] = vn[r] * fast_exp(gl - gc4[r]); }
                    *(LAS v2u*)(L + DS_VN + sl * 2304 + col * 144 + (16 * rb + 4 * q4) * 2) = (v2u){pk2(vn[0], vn[1]), pk2(vn[2], vn[3])};
                    *(LAS v2u*)(L + DS_VS + sl * 2304 + col * 144 + (16 * rb + 4 * q4) * 2) = (v2u){pk2(vs[0], vs[1]), pk2(vs[2], vs[3])};
                } else {
#pragma unroll
                    for (int r = 0; r < 4; ++r) ov[sl][r] = acc[r] * fast_exp(gc4[r]);
                }
            }
        }
        __syncthreads();
        {   bf16x8 fk[2], fq[2];
#pragma unroll
            for (int k2 = 0; k2 < 2; ++k2) { fk[k2] = frag_nat(Ls + DS_KT, 144, 16 * wv + col, q4, k2); fq[k2] = frag_nat(Ls + DS_QK, 144, 16 * rb + col, q4, k2); }
            const float egl = fast_exp(gl);
#pragma unroll
            for (int sl = 0; sl < DN_NSL; ++sl) {
                bf16x8 fv[2];
#pragma unroll
                for (int k2 = 0; k2 < 2; ++k2) fv[k2] = frag_nat(L + DS_VS + sl * 2304, 144, col, q4, k2);
                if (!roleA) { bf16x8 fn[2];
#pragma unroll
                    for (int k2 = 0; k2 < 2; ++k2) fn[k2] = frag_nat(L + DS_VN + sl * 2304, 144, col, q4, k2);
#pragma unroll
                    for (int k2 = 0; k2 < 2; ++k2) ov[sl] = MFMA16(fq[k2], fn[k2], ov[sl]);
                    *(v2u*)(F.ws + WS_VT + (size_t)(bh * NCH + n) * 16384 + (size_t)((((cg * DN_NSL + sl) * 4 + rb) * 64 + lane) * 4) * 2) = (v2u){pk2(ov[sl][0], ov[sl][1]), pk2(ov[sl][2], ov[sl][3])};
                }
                S[sl] = S[sl] * egl;
#pragma unroll
                for (int k2 = 0; k2 < 2; ++k2) S[sl] = MFMA16(fk[k2], fv[k2], S[sl]);
                *(LAS v2u*)(L + DS_ST + sl * 4352 + col * 272 + (16 * wv + 4 * q4) * 2) = (v2u){pk2(S[sl][0], S[sl][1]), pk2(S[sl][2], S[sl][3])};
            }
        }
        if (n + 1 < NCH) DS_WRITE(cur ^ 1);
        __syncthreads();
    }
#undef DS_LOAD
#undef DS_WRITE
    VM_WAIT();
    __syncthreads();
    if (tid == 0) { __builtin_amdgcn_fence(__ATOMIC_RELEASE, "agent"); VM_WAIT(); (void)__hip_atomic_fetch_add((unsigned*)(F.ctl + CW_DNDONE + 64 * bh), 1u, RLX_AGENT); }
}
__device__ __forceinline__ void dn_post_unit(Frame& F, int bh, int n, unsigned& seen) {
    const int b = bh >> 2, h = bh & 3;
    const bf16* BZ = (const bf16*)(F.ws + WS_BZ); bf16* Ob = (bf16*)(F.ws + WS_O);
    if (!((seen >> bh) & 1u)) { seen |= 1u << bh;
      if (F.wave * 64 + LANE_ID() == 0) { unsigned sp = 0;
        while (__hip_atomic_load((unsigned*)(F.ctl + CW_DNDONE + 64 * bh), RLX_AGENT) < (unsigned)(8 / DN_NSL)) { __builtin_amdgcn_s_sleep(4); if (++sp > (1u << 22)) { __hip_atomic_store((unsigned*)(F.ctl + CW_TMO), 1u, RLX_AGENT); break; } }
        __builtin_amdgcn_fence(__ATOMIC_ACQUIRE, "agent"); VM_WAIT(); }
      __syncthreads(); }
    const unsigned char* raw = F.ws + WS_VT + (size_t)(bh * NCH + n) * 16384;
    post_tile(F.wave, F.lds, raw, F.in[I_BOUTG],
              [&](int c) { const int pp = 64 * n + c; return BZ + (size_t)(b * LP + (pp < 48 ? 48 : pp)) * 512 + h * 128; },
              [&](int c) { const int pp = 64 * n + c; return Ob + (size_t)r_of_bp(b, pp < 48 ? 48 : pp) * D + 512 + h * 128; },
              [&](int c) { return 64 * n + c >= 48; });
}

__device__ __forceinline__ void phase_attn(Frame& F, int qword, int mode) {
    const bool do_scan = mode != 1;
    int tz_ = F.wave * 64 + LANE_ID(); asm volatile("" : "+v"(tz_)); const int tid = tz_, lane = tz_ & 63, wave = __builtin_amdgcn_readfirstlane(tz_ >> 6); (void)tid; (void)lane; (void)wave;

    float lam;
    { int tz = F.wave * 64 + LANE_ID(); asm volatile("" : "+v"(tz)); const int ln = tz & 63;
      const float a = F.in[I_LQ1][ln] * F.in[I_LK1][ln], c = F.in[I_LQ2][ln] * F.in[I_LK2][ln]; lam = expf(wave_sum(a)) - expf(wave_sum(c)) + 0.2f; if (tid == 0) F.MISC[5] = __float_as_uint(lam); }
    if (do_scan && blockIdx.x < DN_WGS) dn_scan(F, (int)((blockIdx.x & 7) * (8 / DN_NSL) + (blockIdx.x >> 3)));
    constexpr int NATT = 129, PB = 4, NQ = NATT + (NCH + PB - 1) / PB;
    unsigned seen_dn = 0u;
    for (int qi = 0; qi < 8; ++qi) {
        const int bh = (int)((blockIdx.x + qi) & 7);
        int pn = 0, pe = 0;
        for (;;) {
            if (pn < pe) { if (mode != 1) dn_post_unit(F, bh, pn, seen_dn); ++pn; continue; }
            if (tid == 0) F.MISC[4] = __hip_atomic_fetch_add((unsigned*)(F.ctl + qword + 64 * bh), 1u, RLX_AGENT);
            __syncthreads();
            const int u = __builtin_amdgcn_readfirstlane((int)F.MISC[4]);
            __syncthreads();
            if (u >= NQ) break;
            if (u < NATT) { if (mode != 2) attn_unit(F, bh >> 2, bh & 3, 2 * (128 - u) - 1); }
            else { pn = (u - NATT) * PB; pe = (pn + PB < NCH) ? pn + PB : NCH; }
        }
    }
}

__device__ __forceinline__ void phase_norm(Frame& F, const float* gain, int nrows) {
    int tz_ = F.wave * 64 + LANE_ID(); asm volatile("" : "+v"(tz_)); const int tid = tz_, lane = tz_ & 63, wave = __builtin_amdgcn_readfirstlane(tz_ >> 6); (void)tid; (void)lane; (void)wave;

    const int gw = F.vcu * 8 + wave, NGW = F.G * 8;
    bf16* HN = (bf16*)(F.ws + WS_HN); const float* HM = (const float*)(F.ws + WS_HM);
    for (int r = gw; r < nrows; r += 2 * NGW) {
        const int r2 = r + NGW; const bool has2 = r2 < nrows; const int rb = has2 ? r2 : r;
        const float* srcA = (r < MR) ? F.out + (size_t)r * D : HM + (size_t)(r - MR) * D;
        const float* srcB = (rb < MR) ? F.out + (size_t)rb * D : HM + (size_t)(rb - MR) * D;
        f32x4 va[4], vb[4]; row_load(srcA, lane, va); row_load(srcB, lane, vb);
        float y[16]; rms_finish(va, gain, lane, y); store_row_bf16(HN + (size_t)r * D, lane, y);
        rms_finish(vb, gain, lane, y); if (has2) store_row_bf16(HN + (size_t)r2 * D, lane, y);
    }
}

constexpr int HQ_QA = 0, HQ_KB = 17408, HQ_GS = 34816;
constexpr int HQ_INQ = 40960, HQ_INF = 57344, HQ_OQG = 73728, HQ_OATT = 90112;
#define HG_PF_LOAD(pf_, b_, h_, n_) do { _Pragma("unroll") for (int i_ = 0; i_ < 4; ++i_) { const int idx_ = tid + 512 * i_, which_ = idx_ >> 10, rem_ = idx_ & 1023, rrow_ = rem_ >> 4, ch_ = rem_ & 15; const int pp_ = 64 * (n_) + rrow_; \
        pf_[i_] = *(const v4u*)(P1 + (size_t)r_of_bp((b_), pp_ < 48 ? 48 : pp_) * 4096 + which_ * 1024 + (h_) * 128 + ch_ * 8); } } while (0)
#define HG_PF_WRITE(pf_) do { _Pragma("unroll") for (int i_ = 0; i_ < 4; ++i_) { const int idx_ = tid + 512 * i_, which_ = idx_ >> 10, rem_ = idx_ & 1023, rrow_ = rem_ >> 4, ch_ = rem_ & 15; \
        *(LAS v4u*)(L + (which_ ? HQ_INF : HQ_INQ) + rrow_ * 256 + ch_ * 16) = pf_[i_]; } } while (0)
#define HG_PL_LOAD(pl_, h_) do { pl_[0] = F.in[I_LB][(h_) * 128 + (tid & 127)]; pl_[1] = F.in[I_LB][D + (h_) * 128 + (tid & 127)]; } while (0)
__device__ __forceinline__ void hg_prep_unit(Frame& F, int b, int h, int n, v4u (&pf)[4], float (&pl)[2], int nb, int nh, int nn) {
    LAS unsigned char* L = F.lds;
    int tz = F.wave * 64 + LANE_ID(); asm volatile("" : "+v"(tz));
    const int tid = tz, lane = tz & 63, wave = __builtin_amdgcn_readfirstlane(tz >> 6);
    const bf16* P1 = (const bf16*)(F.ws + WS_PROJ1);
    unsigned char* blob = F.ws + WS_SCAN1 + (size_t)((b * 8 + h) * NCH + n) * HG_BLOB;
    float l0 = pl[0], l1 = pl[1]; asm volatile("" : "+v"(l0), "+v"(l1));
    HG_PL_LOAD(pl, nh); HG_PF_LOAD(pf, nb, nh, nn);
    __syncthreads();
    {
        const int d = tid & 127, g = tid >> 7;
        const float lb = 1.f / (1.f + expf(l0 - l1));
        float c[16], qq[16], kk[16];
        float run = 0.f;
#pragma unroll
        for (int ii = 0; ii < 16; ++ii) { const int pp = 64 * n + 16 * g + ii;
            float q, k, lf;
            { const float q_ = bf2f(*(const LAS bf16*)(L + HQ_INQ + (16 * g + ii) * 256 + d * 2)); const float f = bf2f(*(const LAS bf16*)(L + HQ_INF + (16 * g + ii) * 256 + d * 2));
                const float fg = lb + (1.f - lb) * sigmoidf_(f); const bool ok = pp >= 48; lf = ok ? __builtin_amdgcn_logf(fg) * 0.6931471805599453f : 0.f; k = ok ? 1.f - fg : 0.f; q = ok ? q_ : 0.f; }
            run += lf; c[ii] = run; qq[ii] = q; kk[ii] = k; }
        LAS float* GS = (LAS float*)(L + HQ_GS);
        GS[g * 128 + d] = run;
        __syncthreads();
        const float s0 = GS[d], s1 = GS[128 + d], s2 = GS[256 + d], s3 = GS[384 + d];
        const float off = (g > 0 ? s0 : 0.f) + (g > 1 ? s1 : 0.f) + (g > 2 ? s2 : 0.f), tot = (s0 + s1) + (s2 + s3), gmid = s0 + s1;
        unsigned kd[8];
#pragma unroll
        for (int ii = 0; ii < 16; ++ii) { const int i = 16 * g + ii; const float gc = off + c[ii];
            const float qg = qq[ii] * fast_exp(gc), kdec = kk[ii] * fast_exp(tot - gc);
            const float qa = qq[ii] * fast_exp(fminf(gc - gmid, 80.f)), kb = kk[ii] * fast_exp(fminf(gmid - gc, 80.f));
            *(LAS bf16*)(L + HQ_OQG + (i * 128 + d) * 2) = f2bf(qg);
            *(LAS bf16*)(L + HQ_QA + i * 272 + d * 2) = f2bf(qa); *(LAS bf16*)(L + HQ_KB + i * 272 + d * 2) = f2bf(kb);
            if (ii & 1) kd[ii >> 1] |= ((unsigned)f2bf(kdec)) << 16; else kd[ii >> 1] = (unsigned)f2bf(kdec); }
        *(v4u*)(blob + HG_KDT + (d * 64 + 16 * g) * 2) = (v4u){kd[0], kd[1], kd[2], kd[3]}; *(v4u*)(blob + HG_KDT + (d * 64 + 16 * g) * 2 + 16) = (v4u){kd[4], kd[5], kd[6], kd[7]};
        if (g == 0) *(float*)(blob + HG_DEC + d * 4) = fast_exp(tot);
    }
    __syncthreads();
#pragma unroll
    for (int k = 0; k < 2; ++k) { const int idx = tid + 512 * k; *(v4u*)(blob + HG_QG + idx * 16) = *(const LAS v4u*)(L + HQ_OQG + idx * 16); }
    {
        const int row = lane & 15, quad = lane >> 4;
#pragma unroll
        for (int k = 0; k < 2; ++k) { const int idx = wave + 8 * k, ib = idx >> 2, jb = idx & 3;
            f32x4 acc = (f32x4){0.f, 0.f, 0.f, 0.f};
            if (jb <= ib) {
#pragma unroll
                for (int ks = 0; ks < 4; ++ks) acc = MFMA16(frag_nat(L + HQ_QA, 272, 16 * ib + row, quad, ks), frag_nat(L + HQ_KB, 272, 16 * jb + row, quad, ks), acc);
            }
            const int j = 16 * jb + row;
#pragma unroll
            for (int r = 0; r < 4; ++r) { const int i = 16 * ib + 4 * quad + r; *(LAS bf16*)(L + HQ_OATT + (i * 64 + j) * 2) = f2bf((j <= i) ? acc[r] : 0.f); } }
    }
    __syncthreads();
    const v4u att_ = *(const LAS v4u*)(L + HQ_OATT + tid * 16);
    HG_PF_WRITE(pf);
    *(v4u*)(blob + HG_ATT + tid * 16) = att_;
}
__device__ __forceinline__ void phase_prep1(Frame& F) {
    int tz = F.wave * 64 + LANE_ID(); asm volatile("" : "+v"(tz)); const int tid = tz;
    const bf16* P1 = (const bf16*)(F.ws + WS_PROJ1);
    v4u pf[4]; float pl[2];
    { const int u0 = F.vcu < NB * 8 * NCH ? F.vcu : 0; const int bh0 = u0 / NCH, n0 = u0 % NCH; HG_PL_LOAD(pl, bh0 & 7); HG_PF_LOAD(pf, bh0 >> 3, bh0 & 7, n0); LAS unsigned char* L = F.lds; HG_PF_WRITE(pf); }
    for (int unit = F.vcu; unit < NB * 8 * NCH; unit += F.G) { const int bh = unit / NCH, n = unit % NCH;
        const int un = (unit + F.G < NB * 8 * NCH) ? unit + F.G : unit; const int bhn = un / NCH, nn = un % NCH;
        hg_prep_unit(F, bh >> 3, bh & 7, n, pf, pl, bhn >> 3, bhn & 7, nn); }
}

constexpr int HS_QG = 0, HS_ATT = 17408, HS_KDT = 26624, HS_DEC = 45056, HS_STAGE = 45568, HS_XS = 91136;
__device__ __forceinline__ void hg_scan(Frame& F, int unit) {
    const int bh = unit >> 4, sc = unit & 15, n0 = HG_SC * sc, n1 = (n0 + HG_SC < NCH) ? n0 + HG_SC : NCH;
    LAS unsigned char* L = F.lds;
    const int b = bh >> 3, h = bh & 7;
    int tz = F.wave * 64 + LANE_ID(); asm volatile("" : "+v"(tz));
    const int tid = tz, lane = tz & 63, wv = __builtin_amdgcn_readfirstlane(tz >> 6), col = lane & 15, q4 = lane >> 4, e0 = 16 * wv;
    const unsigned char* blob0 = F.ws + WS_SCAN1 + (size_t)(bh * NCH) * HG_BLOB;
    const bf16* P1 = (const bf16*)(F.ws + WS_PROJ1); bf16* O1 = (bf16*)(F.ws + WS_O1);
    f32x4 S[8], dprod[8];
#pragma unroll
    for (int t = 0; t < 8; ++t) { S[t] = (f32x4){0.f, 0.f, 0.f, 0.f}; dprod[t] = (f32x4){1.f, 1.f, 1.f, 1.f}; }
    v4u pr[5]; float pdec = 0.f;
    const int id0 = tid, id1 = tid + 512;
#define HS_LOAD(n) do { const unsigned char* bl_ = blob0 + (size_t)(n) * HG_BLOB; \
        pr[0] = *(const v4u*)(bl_ + HG_QG + id0 * 16); pr[1] = *(const v4u*)(bl_ + HG_QG + id1 * 16); pr[2] = *(const v4u*)(bl_ + HG_ATT + id0 * 16); \
        pr[3] = *(const v4u*)(bl_ + HG_KDT + id0 * 16); pr[4] = *(const v4u*)(bl_ + HG_KDT + id1 * 16); \
        if (tid < 128) pdec = *(const float*)(bl_ + HG_DEC + tid * 4); } while (0)
#define HS_WRITE(s) do { LAS unsigned char* Ls_ = L + (s) * HS_STAGE; \
        *(LAS v4u*)(Ls_ + HS_QG + (id0 >> 4) * 272 + (id0 & 15) * 16) = pr[0]; *(LAS v4u*)(Ls_ + HS_QG + (id1 >> 4) * 272 + (id1 & 15) * 16) = pr[1]; \
        *(LAS v4u*)(Ls_ + HS_ATT + (id0 >> 3) * 144 + (id0 & 7) * 16) = pr[2]; \
        *(LAS v4u*)(Ls_ + HS_KDT + (id0 >> 3) * 144 + (id0 & 7) * 16) = pr[3]; *(LAS v4u*)(Ls_ + HS_KDT + (id1 >> 3) * 144 + (id1 & 7) * 16) = pr[4]; \
        if (tid < 128) *(LAS float*)(Ls_ + HS_DEC + tid * 4) = pdec; } while (0)
    v4u inx[2];
    LAS unsigned char* ITW = L + PRIV_OFF + wv * 2304;
#define HS_LOADI(n, I) do { const int pp_ = 64 * (n) + lane; const bf16* src_ = P1 + (size_t)r_of_bp(b, pp_ < 48 ? 48 : pp_) * 4096 + 2048 + h * 128 + e0; \
        I[0] = *(const v4u*)src_; I[1] = *(const v4u*)(src_ + 8); if (pp_ < 48) { I[0] = (v4u){0u, 0u, 0u, 0u}; I[1] = (v4u){0u, 0u, 0u, 0u}; } } while (0)
#define HS_WRITEI(I) do { \
        _Pragma("unroll") for (int hf_ = 0; hf_ < 2; ++hf_) { const unsigned w0_ = I[hf_].x, w1_ = I[hf_].y, w2_ = I[hf_].z, w3_ = I[hf_].w; LAS unsigned char* d_ = ITW + (8 * hf_) * 144 + lane * 2; \
            *(LAS bf16*)(d_) = (bf16)(w0_ & 0xffffu); *(LAS bf16*)(d_ + 144) = (bf16)(w0_ >> 16); *(LAS bf16*)(d_ + 288) = (bf16)(w1_ & 0xffffu); *(LAS bf16*)(d_ + 432) = (bf16)(w1_ >> 16); \
            *(LAS bf16*)(d_ + 576) = (bf16)(w2_ & 0xffffu); *(LAS bf16*)(d_ + 720) = (bf16)(w2_ >> 16); *(LAS bf16*)(d_ + 864) = (bf16)(w3_ & 0xffffu); *(LAS bf16*)(d_ + 1008) = (bf16)(w3_ >> 16); } } while (0)
#define HS_LOADZ(n, Z) do { \
        _Pragma("unroll") for (int rb = 0; rb < 4; ++rb) _Pragma("unroll") for (int r = 0; r < 4; ++r) { const int pp_ = 64 * (n) + 16 * rb + 4 * q4 + r; \
            Z[4 * rb + r] = P1[(size_t)(b * SEQ + (pp_ < 64 ? 64 : pp_) - 64) * 4096 + 3072 + h * 128 + e0 + col]; } } while (0)
    HS_LOAD(n0); HS_WRITE(0); HS_LOADI(n0, inx); HS_WRITEI(inx);
    __syncthreads();
    for (int n = n0; n < n1; ++n) {
        const int cur = (n - n0) & 1;
        const LAS unsigned char* Ls = L + cur * HS_STAGE; const LAS float* DEC = (const LAS float*)(Ls + HS_DEC);
        if (n + 1 < n1) { HS_LOAD(n + 1); HS_LOADI(n + 1, inx); }
        bf16x8 Sb[4], ib[2];
#pragma unroll
        for (int ks = 0; ks < 4; ++ks) Sb[ks] = pack_tiles(S[2 * ks], S[2 * ks + 1]);
#pragma unroll
        for (int k2 = 0; k2 < 2; ++k2) ib[k2] = frag_pi(ITW, 144, col, q4, k2);
        f32x4 ov[4];
#pragma unroll
        for (int rh = 0; rh < 2; ++rh) {
            bf16x8 fa[8], fb[4];
#pragma unroll
            for (int r2 = 0; r2 < 2; ++r2) { const int rb = 2 * rh + r2;
#pragma unroll
                for (int ks = 0; ks < 4; ++ks) fa[r2 * 4 + ks] = frag_pi(Ls + HS_QG, 272, 16 * rb + col, q4, ks);
#pragma unroll
                for (int k2 = 0; k2 < 2; ++k2) fb[r2 * 2 + k2] = frag_pi(Ls + HS_ATT, 144, 16 * rb + col, q4, k2); }
            SCHED_BAR();
#pragma unroll
            for (int r2 = 0; r2 < 2; ++r2) { const int rb = 2 * rh + r2; ov[rb] = (f32x4){0.f, 0.f, 0.f, 0.f};
#pragma unroll
                for (int ks = 0; ks < 4; ++ks) ov[rb] = MFMA16(fa[r2 * 4 + ks], Sb[ks], ov[rb]);
#pragma unroll
                for (int k2 = 0; k2 < 2; ++k2) ov[rb] = MFMA16(fb[r2 * 2 + k2], ib[k2], ov[rb]); }
            SCHED_BAR();
        }
#pragma unroll
        for (int th = 0; th < 2; ++th) {
            bf16x8 fa[8]; f32x4 dc[4];
#pragma unroll
            for (int t = 0; t < 4; ++t) { dc[t] = *(const LAS f32x4*)(DEC + 16 * (4 * th + t) + 4 * q4);
#pragma unroll
                for (int k2 = 0; k2 < 2; ++k2) fa[t * 2 + k2] = frag_pi(Ls + HS_KDT, 144, 16 * (4 * th + t) + col, q4, k2); }
            SCHED_BAR();
#pragma unroll
            for (int t = 0; t < 4; ++t) { S[4 * th + t] = S[4 * th + t] * dc[t];
                if (wv == 0 && col == 0) *(f32x4*)((unsigned char*)blob0 + (size_t)n * HG_BLOB + HG_DEC + (16 * (4 * th + t) + 4 * q4) * 4) = dprod[4 * th + t];
                dprod[4 * th + t] = dprod[4 * th + t] * dc[t];
#pragma unroll
                for (int k2 = 0; k2 < 2; ++k2) S[4 * th + t] = MFMA16(fa[t * 2 + k2], ib[k2], S[4 * th + t]); }
            SCHED_BAR();
        }
        { unsigned char* blw = (unsigned char*)blob0 + (size_t)n * HG_BLOB;
#pragma unroll
          for (int rb = 0; rb < 4; ++rb) *(v2u*)(blw + HG_KDT + (size_t)(((wv * 4 + rb) * 64 + lane) * 4) * 2) = (v2u){pk2(ov[rb][0], ov[rb][1]), pk2(ov[rb][2], ov[rb][3])}; }
        if (n + 1 < n1) { HS_WRITE(cur ^ 1); HS_WRITEI(inx); }
        __syncthreads();
    }
#undef HS_LOAD
#undef HS_WRITE
#undef HS_LOADI
#undef HS_WRITEI
#undef HS_LOADZ
    { float* sl = (float*)(F.ws + WS_SLOC) + (size_t)unit * 16384;
#pragma unroll
      for (int t = 0; t < 8; ++t) *(f32x4*)(sl + ((wv * 8 + t) * 64 + lane) * 4) = S[t];
      if (wv == 0 && col == 0) { float* dd = (float*)(F.ws + WS_DECSC) + (size_t)unit * 128;
#pragma unroll
          for (int t = 0; t < 8; ++t) *(f32x4*)(dd + 16 * t + 4 * q4) = dprod[t]; } }
    __syncthreads();
}
__device__ __forceinline__ void phase_hg_carry(Frame& F) {
    int tz_ = F.wave * 64 + LANE_ID(); asm volatile("" : "+v"(tz_));
    const float* SL = (const float*)(F.ws + WS_SLOC); const float* DS = (const float*)(F.ws + WS_DECSC); bf16* ST = (bf16*)(F.ws + WS_SINT);
    for (int g = (int)blockIdx.x * 512 + tz_; g < 16 * 4096; g += F.G * 512) {
        const int bh = g >> 12, gid = g & 4095, wv = gid >> 9, t = (gid >> 6) & 7, ln = gid & 63, q4 = ln >> 4, col = ln & 15, d0 = 16 * t + 4 * q4, e = 16 * wv + col;
        f32x4 s = (f32x4){0.f, 0.f, 0.f, 0.f};
        f32x4 dcv[HG_NSC - 1], lov[HG_NSC - 1];
#pragma unroll
        for (int sc = 0; sc + 1 < HG_NSC; ++sc) { dcv[sc] = *(const f32x4*)(DS + (size_t)(bh * 16 + sc) * 128 + d0); lov[sc] = *(const f32x4*)(SL + (size_t)(bh * 16 + sc) * 16384 + (size_t)gid * 4); }
#pragma unroll
        for (int sc = 0; sc + 1 < HG_NSC; ++sc) {
            const f32x4 dc = dcv[sc], lo = lov[sc];
            s = s * dc + lo;
            *(v2u*)(ST + ((size_t)(bh * 16 + sc + 1) * 128 + e) * 128 + d0) = (v2u){pk2(s[0], s[1]), pk2(s[2], s[3])};
        }
    }
}

__device__ __forceinline__ void phase_hg_post(Frame& F) {
    const bf16* P1 = (const bf16*)(F.ws + WS_PROJ1); bf16* O1 = (bf16*)(F.ws + WS_O1);
    constexpr int NT = 16 * (NCH - 1);
    for (int run = F.vcu; run * 16 < NT; run += F.G) { const int bh = (run * 16) / (NCH - 1), b = bh >> 3, h = bh & 7, na = 1 + (run * 16) % (NCH - 1);
        int staged = -1;
        for (int n = na; n < na + 16 && n < NCH; ++n) { const int sc = n / HG_SC;
            const bf16* sin = (const bf16*)(F.ws + WS_SINT) + (size_t)(bh * 16 + sc) * 16384;
            const unsigned char* blob = F.ws + WS_SCAN1 + (size_t)(bh * NCH + n) * HG_BLOB;
            post_tile(F.wave, F.lds, blob + HG_KDT, F.in[I_COUTG],
                      [&](int c) { return P1 + (size_t)(b * SEQ + 64 * n + c - 64) * 4096 + 3072 + h * 128; },
                      [&](int c) { return O1 + (size_t)(b * SEQ + 64 * n + c - 64) * D + h * 128; },
                      [&](int c) { return true; },
                      sc > 0 ? (const bf16*)(blob + HG_QG) : (const bf16*)nullptr, (const float*)(blob + HG_DEC), (sc > 0 && staged != sc) ? sin : (const bf16*)nullptr);
            staged = sc;
        }
    }
}

__device__ __forceinline__ void phase_route(Frame& F) {
    int tz_ = F.wave * 64 + LANE_ID(); asm volatile("" : "+v"(tz_)); const int tid = tz_, lane = tz_ & 63, wave = __builtin_amdgcn_readfirstlane(tz_ >> 6); (void)tid; (void)lane; (void)wave;

    LAS float* scr = (LAS float*)(F.lds + wave * 8448);
    const int gw = F.vcu * 8 + wave, NGW = F.G * 8;
    unsigned char* WM13 = F.ws + WS_WM13; unsigned char* WM2 = F.ws + WS_WM2;
    constexpr int I_UP = 16 * 112, I_DN = 56 * 32, PER_E = 2 * I_UP + I_DN, NITEMS = NEXP * PER_E;
    int it = gw; const int nitw = (NITEMS - gw + NGW - 1) / NGW; int done = 0;
#define RT_ITEMS(upto) do { while (done < (upto) && it < NITEMS) { const int e = it / PER_E; int r = it % PER_E; \
        if (r < I_UP) transpose_item_fp8<1>(F.in[I_MW1] + (size_t)e * D * DFFE, DFFE, D, DFFE, WM13 + (size_t)e * 7168 * D, 0, scr, r, lane, SC_W13); \
        else if (r < 2 * I_UP) transpose_item_fp8<1>(F.in[I_MW3] + (size_t)e * D * DFFE, DFFE, D, DFFE, WM13 + (size_t)e * 7168 * D, 128, scr, r - I_UP, lane, SC_W13); \
        else transpose_item_fp8<0>(F.in[I_MW2] + (size_t)e * DFFE * D, D, DFFE, D, WM2 + (size_t)e * D * DFFE, 0, scr, r - 2 * I_UP, lane, SC_W2); \
        it += NGW; ++done; } } while (0)
    LAS float* RT = (LAS float*)(F.lds + 69632);
    LAS int* cnt = (LAS int*)(F.lds + 102400);
    for (int k = tid; k < D; k += 512) { const f32x4* p = (const f32x4*)(F.in[I_ROUTER] + (size_t)k * 8); const f32x4 a = p[0], c = p[1];
        RT[0 * D + k] = a[0]; RT[1 * D + k] = a[1]; RT[2 * D + k] = a[2]; RT[3 * D + k] = a[3]; RT[4 * D + k] = c[0]; RT[5 * D + k] = c[1]; RT[6 * D + k] = c[2]; RT[7 * D + k] = c[3]; }
    unsigned char* HN8 = F.ws + WS_HN;
    int* tokinfo = (int*)(F.ws + WS_ROUTE + RT_TOKINFO); int* wgcnt = (int*)(F.ws + WS_ROUTE + RT_WGCNT);
    const float* gain = F.in[I_FFNN] + D;
    bool firstblk = true;
    for (int blk = (int)blockIdx.x; blk < 256; blk += F.G) {
        if (tid < 8) cnt[tid] = 0;
        __syncthreads();
        f32x4 vrow[4]; row_load(F.out + (size_t)(blk * 128 + wave * 16) * D, lane, vrow);
        for (int rr = 0; rr < 16; ++rr) {
            const int t = blk * 128 + wave * 16 + rr;
            float y[16]; rms_finish_exact(vrow, gain, lane, y);
            row_load(F.out + (size_t)(rr < 15 ? t + 1 : t) * D, lane, vrow);
            { unsigned* o4 = (unsigned*)(HN8 + (size_t)t * D) + lane;
#pragma unroll
              for (int j = 0; j < 4; ++j) o4[64 * j] = pk4_fp8(y[4 * j] * SC_X, y[4 * j + 1] * SC_X, y[4 * j + 2] * SC_X, y[4 * j + 3] * SC_X); }
            float lg[8];
#pragma unroll
            for (int j = 0; j < 8; ++j) { float s = 0.f;
#pragma unroll
                for (int jj = 0; jj < 4; ++jj) { const f32x4 w = *(const LAS f32x4*)(RT + j * D + 4 * lane + 256 * jj); s += y[4 * jj] * w[0] + y[4 * jj + 1] * w[1] + y[4 * jj + 2] * w[2] + y[4 * jj + 3] * w[3]; }
                lg[j] = wave_sum(s); }
            int e0 = 0; float v0 = lg[0];
#pragma unroll
            for (int j = 1; j < 8; ++j) if (lg[j] > v0) { v0 = lg[j]; e0 = j; }
            int e1 = -1; float v1 = -INFINITY;
#pragma unroll
            for (int j = 0; j < 8; ++j) if (j != e0 && lg[j] > v1) { v1 = lg[j]; e1 = j; }
            const float g0 = 1.f / (1.f + expf(v1 - v0));
            if (lane == 0) {
                const int r0 = __hip_atomic_fetch_add(cnt + e0, 1, __ATOMIC_RELAXED, __HIP_MEMORY_SCOPE_WORKGROUP), r1 = __hip_atomic_fetch_add(cnt + e1, 1, __ATOMIC_RELAXED, __HIP_MEMORY_SCOPE_WORKGROUP);
                *(int4*)(tokinfo + (size_t)t * 4) = make_int4(e0 | (e1 << 8), __float_as_int(g0), r0, r1); }
            if (firstblk) RT_ITEMS(((rr + 1) * nitw) >> 4);
        }
        firstblk = false;
        __syncthreads();
        if (tid < 8) wgcnt[blk * 8 + tid] = cnt[tid];
        __syncthreads();
    }
    RT_ITEMS(nitw);
#undef RT_ITEMS
}
__device__ __forceinline__ void phase_gather(Frame& F) {
    int tz_ = F.wave * 64 + LANE_ID(); asm volatile("" : "+v"(tz_)); const int tid = tz_, lane = tz_ & 63, wave = __builtin_amdgcn_readfirstlane(tz_ >> 6); (void)tid; (void)lane; (void)wave;

    LAS int* T = (LAS int*)F.lds;
    LAS int* PERS = (LAS int*)(F.lds + PERS_OFF);
    const int* wgcnt = (const int*)(F.ws + WS_ROUTE + RT_WGCNT);
    int* tokinfo = (int*)(F.ws + WS_ROUTE + RT_TOKINFO); int* rowtok = (int*)(F.ws + WS_ROUTE + RT_ROWTOK); float* rowgate = (float*)(F.ws + WS_ROUTE + RT_ROWGATE);
    const unsigned char* HN8 = F.ws + WS_HN; unsigned char* XG = F.ws + WS_XG;
    { const int e = wave;
      int c4[4], ssum = 0;
#pragma unroll
      for (int i = 0; i < 4; ++i) { c4[i] = wgcnt[(4 * lane + i) * 8 + e]; ssum += c4[i]; }
      int incl = ssum;
#pragma unroll
      for (int o = 1; o < 64; o <<= 1) { const int t = __shfl_up(incl, o); if (lane >= o) incl += t; }
      int run = incl - ssum;
#pragma unroll
      for (int i = 0; i < 4; ++i) { T[32 + (4 * lane + i) * 8 + e] = run; run += c4[i]; }
      if (lane == 63) T[e] = incl; }
    __syncthreads();
    if (tid == 0) { int ps = 0; for (int e = 0; e < 8; ++e) { T[8 + e] = ps; ps += (T[e] + 255) / 256 * 256; T[16 + e] = ps; PERS[e] = ps; } PERS[8] = ps / 256; }
    __syncthreads();
    { const int ntl = PERS[8]; LAS unsigned char* te = (LAS unsigned char*)(PERS + 16);
      for (int t = tid; t < ntl; t += 512) { int e = 0; while (e < 7 && PERS[e] <= 256 * t) ++e; te[t] = (unsigned char)e; } }
    for (int blk = (int)blockIdx.x; blk < 256; blk += F.G) {
        for (int pi = wave; pi < 256; pi += 8) {
            const int t = blk * 128 + (pi >> 1), s = pi & 1;
            const int4 ti = *(const int4*)(tokinfo + (size_t)t * 4);
            const int e = s ? ((ti.x >> 8) & 0xff) : (ti.x & 0xff); const float g0 = __int_as_float(ti.y); const float g = s ? 1.f - g0 : g0; const int rank = s ? ti.w : ti.z;
            const int dest = T[8 + e] + T[32 + blk * 8 + e] + rank;
            *((v4u*)(XG + (size_t)dest * D) + lane) = *((const v4u*)(HN8 + (size_t)t * D) + lane);
            if (lane == 0) { rowtok[dest] = t; rowgate[dest] = g; tokinfo[(size_t)t * 4 + 2 + s] = dest; }
        }
    }
    if (blockIdx.x < 8) { const int e = (int)blockIdx.x; const int lo = T[8 + e] + T[e], hi = T[16 + e];
        for (int r = lo + wave; r < hi; r += 8) { v2u* dst = (v2u*)(XG + (size_t)r * D) + lane; dst[0] = (v2u){0u, 0u}; dst[64] = (v2u){0u, 0u}; if (lane == 0) { rowtok[r] = -1; rowgate[r] = 0.f; } } }
}
struct MoeOrder {
    pg8::StaticOrder so; int tile0, slot0; bool up; const LAS unsigned char* te;
    int nd, take;
    __device__ bool next(int i, Unit& u) const {
        long L;
        if (nd == 0) L = (long)i * so.G + so.c;
        else if (so.c < nd) { if (i >= take) return false; L = (long)so.c * take + i; }
        else L = (long)nd * take + (so.c - nd) + (long)i * (so.G - nd);
        if (!so.map(L, u)) return false;
        const int tile = tile0 + u.pm; const int e = te[tile];
        if (up) { u.arow = tile * 256; u.brow = e * 7168 + u.pn * 256; u.orow = (slot0 + u.pm) * 256; }
        else { u.arow = (slot0 + u.pm) * 256; u.brow = e * 1024 + u.pn * 256; u.orow = tile * 256; }
        u.pm = tile; u.nrow = 256; return true;
    }
};
__device__ __forceinline__ void phase_combine(Frame& F) {
    int tz_ = F.wave * 64 + LANE_ID(); asm volatile("" : "+v"(tz_)); const int tid = tz_, lane = tz_ & 63, wave = __builtin_amdgcn_readfirstlane(tz_ >> 6); (void)tid; (void)lane; (void)wave;

    const int gw = F.vcu * 8 + wave, NGW = F.G * 8;
    const int* tokinfo = (const int*)(F.ws + WS_ROUTE + RT_TOKINFO); const bf16* Y = (const bf16*)(F.ws + WS_Y);
    static_assert(MR % 2 == 0, "token pairs");
    for (int t = 2 * gw; t < MR; t += 2 * NGW) {
        const int4 tA = *(const int4*)(tokinfo + (size_t)t * 4), tB = *(const int4*)(tokinfo + (size_t)(t + 1) * 4);
        f32x4* oA = (f32x4*)(F.out + (size_t)t * D) + lane; f32x4* oB = oA + D / 4;
        const v2u* a0 = (const v2u*)(Y + (size_t)tA.z * D) + lane; const v2u* a1 = (const v2u*)(Y + (size_t)tA.w * D) + lane;
        const v2u* b0 = (const v2u*)(Y + (size_t)tB.z * D) + lane; const v2u* b1 = (const v2u*)(Y + (size_t)tB.w * D) + lane;
        f32x4 vA[4], vB[4]; v2u pa[4], pc[4], qa[4], qc[4];
#pragma unroll
        for (int j = 0; j < 4; ++j) { vA[j] = oA[64 * j]; pa[j] = a0[64 * j]; pc[j] = a1[64 * j]; vB[j] = oB[64 * j]; qa[j] = b0[64 * j]; qc[j] = b1[64 * j]; }
#pragma unroll
        for (int j = 0; j < 4; ++j) { f32x4 v = vA[j]; v[0] += bflo(pa[j].x) + bflo(pc[j].x); v[1] += bfhi(pa[j].x) + bfhi(pc[j].x); v[2] += bflo(pa[j].y) + bflo(pc[j].y); v[3] += bfhi(pa[j].y) + bfhi(pc[j].y); oA[64 * j] = v; }
#pragma unroll
        for (int j = 0; j < 4; ++j) { f32x4 v = vB[j]; v[0] += bflo(qa[j].x) + bflo(qc[j].x); v[1] += bfhi(qa[j].x) + bfhi(qc[j].x); v[2] += bflo(qa[j].y) + bflo(qc[j].y); v[3] += bfhi(qa[j].y) + bfhi(qc[j].y); oB[64 * j] = v; }
    }
}


template <bool PAIR, int K, class EE>
__device__ __forceinline__ void meta_gemm(Frame& F, const bf16* A, const bf16* Bt, int nblk, const EE& epi) {
    int tz_ = F.wave * 64 + LANE_ID(); asm volatile("" : "+v"(tz_)); const int tid = tz_, lane = tz_ & 63, wave = __builtin_amdgcn_readfirstlane(tz_ >> 6);
    LAS float* red = (LAS float*)F.lds;
    const int row = lane & 15, quad = lane >> 4; constexpr int kw = K / 8;
    for (int b = F.vcu; b < nblk; b += F.G) {
        const int brow0 = PAIR ? ((16 * b) >> 7) * 256 + ((16 * b) & 127) : 16 * b;
        f32x4 a00 = (f32x4){0.f, 0.f, 0.f, 0.f}, a01 = a00, a10 = a00, a11 = a00;
        const bf16* ap = A + (size_t)row * K + wave * kw + 8 * quad; const bf16* bp = Bt + (size_t)(brow0 + row) * K + wave * kw + 8 * quad;
#pragma unroll 4
        for (int k = 0; k < kw; k += 32) {
            const bf16x8 x0 = *(const bf16x8*)(ap + k), x1 = *(const bf16x8*)(ap + (size_t)16 * K + k), w0 = *(const bf16x8*)(bp + k);
            a00 = MFMA16(x0, w0, a00); a01 = MFMA16(x1, w0, a01);
            if (PAIR) { const bf16x8 w1 = *(const bf16x8*)(bp + (size_t)128 * K + k); a10 = MFMA16(x0, w1, a10); a11 = MFMA16(x1, w1, a11); }
        }
#pragma unroll
        for (int r = 0; r < 4; ++r) { red[(wave * 32 + 4 * quad + r) * 16 + row] = a00[r]; red[(wave * 32 + 16 + 4 * quad + r) * 16 + row] = a01[r];
            if (PAIR) { red[4096 + (wave * 32 + 4 * quad + r) * 16 + row] = a10[r]; red[4096 + (wave * 32 + 16 + 4 * quad + r) * 16 + row] = a11[r]; } }
        __syncthreads();
        { const int rr = tid >> 4, cc = tid & 15; float v = 0.f, v2 = 0.f;
#pragma unroll
          for (int w = 0; w < 8; ++w) { v += red[(w * 32 + rr) * 16 + cc]; if (PAIR) v2 += red[4096 + (w * 32 + rr) * 16 + cc]; }
          epi(rr, 16 * b + cc, v, v2); }
        __syncthreads();
    }
}
constexpr int N_PHASES = 23;
#ifndef MK_PER_PHASE
#define MK_PER_PHASE 0
#endif
struct Args { const float* in[28]; float* out; unsigned char* ws; int ph_lo, ph_hi, dup, pad; };
__global__ void __launch_bounds__(512, 2) mk_fwd(Args args) {
    extern __shared__ __attribute__((aligned(16))) unsigned char lds[];
    Frame F;
    F.lds = (LAS unsigned char*)lds;
    F.MISC = (volatile LAS unsigned*)(F.lds + MISC_OFF);
    F.wave = __builtin_amdgcn_readfirstlane((int)threadIdx.x >> 6); F.tid = F.wave * 64 + LANE_ID(); F.lane = F.tid & 63;
    F.G = gridDim.x; { const int bx = blockIdx.x; F.vcu = (F.G % 8 == 0) ? (bx % 8) * (F.G / 8) + bx / 8 : bx; }
    F.ws = args.ws; F.ctl = (gu32*)(args.ws + WS_CTL); F.out = args.out;
    F.in.base = (const __attribute__((address_space(4))) unsigned long long*)__builtin_amdgcn_kernarg_segment_ptr();
    for (int u = F.tid; u < (LDS_BYTES - LDSCTL_OFF) / 4; u += 512) ((LAS unsigned*)(F.lds + LDSCTL_OFF))[u] = 0u;
    __syncthreads();
    XcdBarrier bar = xcd_barrier_post((unsigned*)(F.ctl + CW_BAR), F.MISC + 8, F.wave);
    const int lo = args.ph_lo, hi = args.ph_hi;
#define IN(k) (lo <= (k) && (k) < hi)
#define SEAM(k) do { if (IN(k) && IN((k) + 1)) xcd_barrier(bar); } while (0)
#ifndef DUP_MASK
#define DUP_MASK 0u
#endif
#ifndef ATT_PROBE_MODE
#define ATT_PROBE_MODE 0
#endif
#define NREP(k) ((int)((DUP_MASK >> (k)) & 1u) * args.dup + 1)
    unsigned char* ws = args.ws;
    bf16* HN = (bf16*)(ws + WS_HN); float* HM = (float*)(ws + WS_HM);

    if (IN(0)) { for (int rep = 0; rep < NREP(0); ++rep) { if (rep) xcd_barrier(bar); phase_prologue(F); } } SEAM(0);
    if (IN(1)) for (int rep = 0; rep < NREP(1); ++rep) {
        if (rep) xcd_barrier(bar);
        pg8::Gemm g{HN, (const bf16*)(ws + WS_WIN0), D}; pg8::StaticOrder S; S.init(MR / 256, NPROJ0 / 256, F.G, (int)blockIdx.x);
        EpiProj0 E{(bf16*)(ws + WS_Q), (bf16*)(ws + WS_K), (bf16*)(ws + WS_VR), (bf16*)(ws + WS_CRAW), (bf16*)(ws + WS_BZ)};
        { bf16* Qm = (bf16*)(ws + WS_Q); bf16* Km = (bf16*)(ws + WS_K); bf16* Vm = (bf16*)(ws + WS_VR); bf16* Cm = (bf16*)(ws + WS_CRAW); bf16* Zm = (bf16*)(ws + WS_BZ);
          meta_gemm<false, D>(F, HN + (size_t)MR * D, g.Bt, NPROJ0 / 16, [&](int r, int c, float v, float) { const size_t pr = (size_t)prow_of_r(MR + r);
              if (c < 512) Qm[pr * 512 + c] = f2bf(v); else if (c < 1024) Km[pr * 512 + c - 512] = f2bf(v); else if (c < 1536) Vm[pr * 512 + c - 1024] = f2bf(v);
              else if (c < 3072) Cm[pr * 1536 + c - 1536] = f2bf(v); else Zm[pr * 512 + c - 3072] = f2bf(v); }); }
        pg8::gemm_phase(F.wave, F.lds, g, S, E); } SEAM(1);
    if (IN(2)) { phase_prep0(F, true); for (int rep = 1; rep < NREP(2); ++rep) { xcd_barrier(bar); phase_prep0(F, false); } } SEAM(2);
#ifndef SPLIT_P3
#define SPLIT_P3 0
#endif
    if (IN(3)) { if (SPLIT_P3) { phase_attn(F, CW_QHEAD, 2); xcd_barrier(bar); phase_attn(F, CW_QHEAD + 512, 1); }
        else for (int rep = 0; rep < NREP(3); ++rep) { if (rep) xcd_barrier(bar); phase_attn(F, CW_QHEAD + 512 * rep, rep == 0 ? 0 : ATT_PROBE_MODE); } } SEAM(3);
    if (IN(4)) {
        pg8::Gemm g{(const bf16*)(ws + WS_O), (const bf16*)(ws + WS_WOUT0), D}; pg8::StaticOrder S; S.init(MR / 256, 4, F.G, (int)blockIdx.x);
        EpiResid E{F.in[I_X], F.in[I_META], 15, F.out, HM};
        { const float* mt = F.in[I_META]; meta_gemm<false, D>(F, g.A + (size_t)MR * D, g.Bt, D / 16, [&](int r, int c, float v, float) { HM[(size_t)r * D + c] = mt[(size_t)(r & 15) * D + c] + v; }); }
        pg8::gemm_phase(F.wave, F.lds, g, S, E); } SEAM(4);
    if (IN(5)) { for (int rep = 0; rep < NREP(5); ++rep) { if (rep) xcd_barrier(bar); phase_norm(F, F.in[I_FFNN], MROWS); } } SEAM(5);
    if (IN(6)) for (int rep = 0; rep < NREP(6); ++rep) {
        if (rep) xcd_barrier(bar);
        pg8::Gemm g{HN, (const bf16*)(ws + WS_W13), D}; pg8::StaticOrder S; S.init(MR / 256, 2 * DFF / 256, F.G, (int)blockIdx.x);
        EpiSwiglu E{(bf16*)(ws + WS_H0), DFF};
        { bf16* Hm = (bf16*)(ws + WS_H0) + (size_t)MR * DFF; meta_gemm<true, D>(F, HN + (size_t)MR * D, g.Bt, DFF / 16, [&](int r, int c, float a, float b2) { Hm[(size_t)r * DFF + c] = f2bf(siluf_(a) * b2); }); }
        pg8::gemm_phase(F.wave, F.lds, g, S, E); } SEAM(6);
    if (IN(7)) {
        pg8::Gemm g{(const bf16*)(ws + WS_H0), (const bf16*)(ws + WS_W2), DFF}; pg8::StaticOrder S; S.init(MR / 256, 4, F.G, (int)blockIdx.x);
        EpiResid E{F.out, HM, 31, F.out, HM};
        meta_gemm<false, DFF>(F, g.A + (size_t)MR * DFF, g.Bt, D / 16, [&](int r, int c, float v, float) { HM[(size_t)r * D + c] += v; });
        pg8::gemm_phase(F.wave, F.lds, g, S, E); } SEAM(7);
    if (IN(8)) { for (int rep = 0; rep < NREP(8); ++rep) { if (rep) xcd_barrier(bar); phase_norm(F, F.in[I_MIXN] + D, MROWS); } } SEAM(8);
    if (IN(9)) for (int rep = 0; rep < NREP(9); ++rep) {
        if (rep) xcd_barrier(bar);
        pg8::Gemm g{HN, (const bf16*)(ws + WS_WIN1), D}; pg8::StaticOrder S; S.init(MR / 256, 16, F.G, (int)blockIdx.x);
        EpiBf16 E{(bf16*)(ws + WS_PROJ1), 4096};
        { bf16* Pm = (bf16*)(ws + WS_PROJ1) + (size_t)MR * 4096; meta_gemm<false, D>(F, HN + (size_t)MR * D, g.Bt, 4096 / 16, [&](int r, int c, float v, float) { Pm[(size_t)r * 4096 + c] = f2bf(v); }); }
        pg8::gemm_phase(F.wave, F.lds, g, S, E); } SEAM(9);
    if (IN(10)) { for (int rep = 0; rep < NREP(10); ++rep) { if (rep) xcd_barrier(bar); phase_prep1(F); } } SEAM(10);
    if (IN(11)) { for (int unit = (int)blockIdx.x; unit < 256; unit += F.G) hg_scan(F, unit); } SEAM(11);
    if (IN(12)) { for (int rep = 0; rep < NREP(12); ++rep) { if (rep) xcd_barrier(bar); phase_hg_carry(F); } } SEAM(12);
    if (IN(13)) { for (int rep = 0; rep < NREP(13); ++rep) { if (rep) xcd_barrier(bar); phase_hg_post(F); } } SEAM(13);
    if (IN(14)) {
        pg8::Gemm g{(const bf16*)(ws + WS_O1), (const bf16*)(ws + WS_WOUT1), D}; pg8::StaticOrder S; S.init(MR / 256, 4, F.G, (int)blockIdx.x);
        EpiResid E{F.out, HM, 31, F.out, HM};
        pg8::gemm_phase(F.wave, F.lds, g, S, E); } SEAM(14);
    if (IN(15)) { for (int rep = 0; rep < NREP(15); ++rep) { if (rep) xcd_barrier(bar); phase_route(F); } } SEAM(15);
    if (IN(16)) { phase_gather(F); } SEAM(16);
#define MOE_ORDER(S, ntp_, nN_, tile0_, slot0_, up_, nd_, take_) MoeOrder S; S.so.init((ntp_), (nN_), F.G, (int)blockIdx.x); S.tile0 = (tile0_); S.slot0 = (slot0_); S.up = (up_); S.te = (const LAS unsigned char*)(PERS + 16); S.nd = (nd_); S.take = (take_)
#define MOE_UP(S) do { pg8::Gemm g{(const bf16*)(ws + WS_XG), (const bf16*)(ws + WS_WM13), D / 2}; EpiSwiglu8 E{ws + WS_HMOE, DFFE, 1.f / (SC_X * SC_W13)}; pg8::gemm_phase<EpiSwiglu8, MoeOrder, true>(F.wave, F.lds, g, S, E); } while (0)
#define MOE_DOWN(S) do { pg8::Gemm g{(const bf16*)(ws + WS_HMOE), (const bf16*)(ws + WS_WM2), DFFE / 2}; EpiMoeDown E{(bf16*)(ws + WS_Y), (const float*)(ws + WS_ROUTE + RT_ROWGATE), 1.f / (SC_H * SC_W2)}; pg8::gemm_phase<EpiMoeDown, MoeOrder, true>(F.wave, F.lds, g, S, E); } while (0)
    if (IN(17)) { const LAS int* PERS = (const LAS int*)(F.lds + PERS_OFF); const int nl = PERS[8] - 256; MOE_ORDER(S, nl, 28, 256, 128, true, 0, 0); MOE_UP(S); } SEAM(17);
    if (IN(18)) { const LAS int* PERS = (const LAS int*)(F.lds + PERS_OFF); const int nl = PERS[8] - 256, nd = 4 * nl;
        { MOE_ORDER(S, nl, 4, 256, 128, false, 0, 0); MOE_DOWN(S); }
        { MOE_ORDER(S, 128, 28, 0, 0, true, nd, 10); MOE_UP(S); } } SEAM(18);
    if (IN(19)) { const LAS int* PERS = (const LAS int*)(F.lds + PERS_OFF); MOE_ORDER(S, 128, 4, 0, 0, false, 0, 0); MOE_DOWN(S); } SEAM(19);
    if (IN(20)) { const LAS int* PERS = (const LAS int*)(F.lds + PERS_OFF); MOE_ORDER(S, 128, 28, 128, 0, true, 0, 0); MOE_UP(S); } SEAM(20);
    if (IN(21)) { const LAS int* PERS = (const LAS int*)(F.lds + PERS_OFF); MOE_ORDER(S, 128, 4, 128, 0, false, 0, 0); MOE_DOWN(S); } SEAM(21);
    if (IN(22)) { phase_combine(F); }
#undef IN
#undef SEAM
}

extern "C" void kernel_launch(void* const* d_in, const int* in_sizes, int n_in, void* d_out, int out_size, void* d_ws, size_t ws_size, hipStream_t stream) {
    static int grid = 0;
    if (grid == 0) {
        if (n_in != 28 || out_size != MR * D || ws_size < WS_END) { fprintf(stderr, "kernel_launch: unexpected problem (n_in %d, out %d, ws %zu)\n", n_in, out_size, ws_size); grid = -1; return; }
        int dev = 0, cus = 0;
        if (hipGetDevice(&dev) != hipSuccess || hipDeviceGetAttribute(&cus, hipDeviceAttributeMultiprocessorCount, dev) != hipSuccess) { grid = -1; return; }
        if (hipFuncSetAttribute((const void*)mk_fwd, hipFuncAttributeMaxDynamicSharedMemorySize, LDS_BYTES) != hipSuccess) { grid = -1; return; }
        int per_cu = 0;
        if (hipOccupancyMaxActiveBlocksPerMultiprocessor(&per_cu, (const void*)mk_fwd, 512, LDS_BYTES) != hipSuccess || per_cu < 1) { (void)hipGetLastError(); }
        grid = cus;
    }
    if (grid < 0) return;
    (void)hipMemsetAsync((char*)d_ws + WS_CTL, 0, CTL_ZERO_BYTES, stream);
    Args a{};
    for (int i = 0; i < 28; ++i) a.in[i] = (const float*)d_in[i];
    a.out = (float*)d_out; a.ws = (unsigned char*)d_ws; a.dup = 1;
#if MK_PER_PHASE
    for (int p = 0; p < N_PHASES; ++p) { a.ph_lo = p; a.ph_hi = p + 1; hipLaunchKernelGGL(mk_fwd, dim3(grid), dim3(512), LDS_BYTES, stream, a); }
#else
    a.ph_lo = 0; a.ph_hi = N_PHASES;
    hipLaunchKernelGGL(mk_fwd, dim3(grid), dim3(512), LDS_BYTES, stream, a);
#endif
}
```
